# Optimizing an MI355X kernel written in HIP

```python
import math
import jax, jax.numpy as jnp
from jax import lax
import numpy as np


D_MODEL = 1024
BATCH = 2
SEQ = 8192
DEPTH = 1

HEAD_DIM = 64
DSA_HEADS = 8
DSA_WIDTH = DSA_HEADS * HEAD_DIM
IDX_HEADS = 8
IDX_DIM = 32
TOPK_MAX = 256
DIFF_HEADS = 4
DIFF_DIM = 64
DIFF_VDIM = 2 * DIFF_DIM
DIFF_QK_WIDTH = DIFF_HEADS * 2 * DIFF_DIM
DIFF_WIDTH = DIFF_HEADS * DIFF_VDIM
DIFF_SUBLN_EPS = 1e-5
N_BRANCH = 2
ROPE_THETA = 500000.0
ROT_FRACTION = 4
ROT_DIM_HEAD = HEAD_DIM // ROT_FRACTION
ROT_DIM_IDX = IDX_DIM // ROT_FRACTION
Q_BLOCK = 128
FFN_MULT = 256
D_FF = -(-8 * D_MODEL // (3 * FFN_MULT)) * FFN_MULT
NORM_EPS = 1e-6

IN_SPLITS = (
    DSA_WIDTH,
    DSA_WIDTH,
    DSA_WIDTH,
    IDX_HEADS * IDX_DIM,
    IDX_DIM,
    IDX_HEADS,
    DIFF_QK_WIDTH,
    DIFF_QK_WIDTH,
    DIFF_WIDTH,
    N_BRANCH * D_MODEL,
)
D_IN = sum(IN_SPLITS)

kernel_name = 'hybrid_dsa_diffattn_gated_block'


def rmsnorm(x, g, eps=NORM_EPS):
    xf = x.astype(jnp.float32)
    y = xf * lax.rsqrt(jnp.mean(xf * xf, axis=-1, keepdims=True) + eps)
    return (y * g.astype(jnp.float32)).astype(x.dtype)


def layernorm(x, g, b, eps=NORM_EPS):
    xf = x.astype(jnp.float32)
    mu = jnp.mean(xf, axis=-1, keepdims=True)
    xc = xf - mu
    y = xc * lax.rsqrt(jnp.mean(xc * xc, axis=-1, keepdims=True) + eps)
    return (y * g.astype(jnp.float32) + b.astype(jnp.float32)).astype(x.dtype)


def rope_tables(positions, rot_dim):
    inv_freq = jnp.power(jnp.float32(ROPE_THETA), -jnp.arange(0, rot_dim, 2, dtype=jnp.float32) / rot_dim)
    ang = positions.astype(jnp.float32)[..., None] * inv_freq
    return jnp.cos(ang), jnp.sin(ang)


def apply_partial_rope(x, cos, sin):
    half = cos.shape[-1]
    x1 = x[..., :half]
    x2 = x[..., half:2 * half]
    xp = x[..., 2 * half:]
    c = cos[:, :, None, :].astype(x.dtype)
    s = sin[:, :, None, :].astype(x.dtype)
    return jnp.concatenate([x1 * c - x2 * s, x2 * c + x1 * s, xp], axis=-1)


def split_columns(proj):
    outs = []
    start = 0
    for size in IN_SPLITS:
        outs.append(proj[..., start:start + size])
        start += size
    return outs


def dsa_sparse_attention(q, k, v, q_idx, k_idx, w_idx, n_top):
    B, S = q.shape[0], q.shape[1]
    att_scale = HEAD_DIM ** -0.5
    w_idx = w_idx * (IDX_HEADS ** -0.5 * IDX_DIM ** -0.5)
    s_pos = jnp.arange(S)

    def block(i):
        q0 = i * Q_BLOCK
        qb = lax.dynamic_slice_in_dim(q, q0, Q_BLOCK, axis=1)
        qib = lax.dynamic_slice_in_dim(q_idx, q0, Q_BLOCK, axis=1)
        wib = lax.dynamic_slice_in_dim(w_idx, q0, Q_BLOCK, axis=1)
        t_pos = q0 + jnp.arange(Q_BLOCK)
        causal = s_pos[None, :] <= t_pos[:, None]
        logits = jnp.einsum('bqhd,bsd->bqhs', qib, k_idx)
        score = jnp.einsum('bqhs,bqh->bqs', jax.nn.relu(logits), wib).astype(jnp.float32)
        score = jnp.where(causal[None], score, -jnp.inf)
        _, sel = lax.top_k(score, n_top)
        valid = sel <= t_pos[None, :, None]
        kg = jax.vmap(lambda kb, ib: kb[ib])(k, sel)
        vg = jax.vmap(lambda vb, ib: vb[ib])(v, sel)
        sc = jnp.einsum('bqhd,bqkhd->bhqk', qb, kg).astype(jnp.float32) * att_scale
        sc = jnp.where(valid[:, None], sc, -jnp.inf)
        p = jax.nn.softmax(sc, axis=-1).astype(v.dtype)
        return jnp.einsum('bhqk,bqkhd->bqhd', p, vg)

    out = lax.map(block, jnp.arange(S // Q_BLOCK))
    return jnp.moveaxis(out, 0, 1).reshape(B, S, DSA_WIDTH)


def differential_attention(q, k, v, lam):
    B, S = q.shape[0], q.shape[1]
    scale = DIFF_DIM ** -0.5
    s_pos = jnp.arange(S)

    def block(i):
        q0 = i * Q_BLOCK
        qb = lax.dynamic_slice_in_dim(q, q0, Q_BLOCK, axis=1)
        t_pos = q0 + jnp.arange(Q_BLOCK)
        causal = s_pos[None, :] <= t_pos[:, None]
        sc = jnp.einsum('bqhmd,bshmd->bhmqs', qb, k).astype(jnp.float32) * scale
        sc = jnp.where(causal, sc, -jnp.inf)
        a = jax.nn.softmax(sc, axis=-1)
        a = a[:, :, 0] - lam * a[:, :, 1]
        return jnp.einsum('bhqs,bshe->bqhe', a.astype(v.dtype), v)

    out = lax.map(block, jnp.arange(S // Q_BLOCK))
    return jnp.moveaxis(out, 0, 1).reshape(B, S, DIFF_HEADS, DIFF_VDIM)


def setup_inputs(seed: int = 0) -> dict:
    key = jax.random.key(seed)
    ks = jax.random.split(key, 20)
    f32 = jnp.float32

    def normal(k, shape, std):
        return jax.random.normal(k, shape, dtype=f32) * std

    def gain(k, shape):
        return 1.0 + normal(k, shape, 0.02)

    return {
        'x': normal(ks[0], (BATCH, SEQ, D_MODEL), 1.0),
        'positions': jnp.broadcast_to(jnp.arange(SEQ, dtype=jnp.int32), (BATCH, SEQ)),
        'norm_mix_g': gain(ks[1], (DEPTH, D_MODEL)),
        'w_in': normal(ks[2], (DEPTH, D_MODEL, D_IN), D_MODEL ** -0.5),
        'idx_k_norm_g': gain(ks[3], (DEPTH, IDX_DIM)),
        'idx_k_norm_b': normal(ks[4], (DEPTH, IDX_DIM), 0.02),
        'diff_lambda_q1': normal(ks[5], (DEPTH, DIFF_DIM), 0.1),
        'diff_lambda_k1': normal(ks[6], (DEPTH, DIFF_DIM), 0.1),
        'diff_lambda_q2': normal(ks[7], (DEPTH, DIFF_DIM), 0.1),
        'diff_lambda_k2': normal(ks[8], (DEPTH, DIFF_DIM), 0.1),
        'diff_subln_g': gain(ks[9], (DEPTH, DIFF_VDIM)),
        'gate_b': normal(ks[10], (DEPTH, N_BRANCH * D_MODEL), 0.02),
        'w_branch_dsa': normal(ks[11], (DEPTH, DSA_WIDTH, D_MODEL), DSA_WIDTH ** -0.5),
        'w_branch_diff': normal(ks[12], (DEPTH, DIFF_WIDTH, D_MODEL), DIFF_WIDTH ** -0.5),
        'w_out': normal(ks[13], (DEPTH, D_MODEL, D_MODEL), D_MODEL ** -0.5),
        'norm_ffn_g': gain(ks[14], (DEPTH, D_MODEL)),
        'w_ffn_in': normal(ks[15], (DEPTH, D_MODEL, 2 * D_FF), D_MODEL ** -0.5),
        'w_ffn_out': normal(ks[16], (DEPTH, D_FF, D_MODEL), D_FF ** -0.5),
        'norm_final_g': gain(ks[17], (D_MODEL,)),
    }


def reference(x, positions, norm_mix_g, w_in, idx_k_norm_g, idx_k_norm_b,
              diff_lambda_q1, diff_lambda_k1, diff_lambda_q2, diff_lambda_k2,
              diff_subln_g, gate_b, w_branch_dsa, w_branch_diff, w_out,
              norm_ffn_g, w_ffn_in, w_ffn_out, norm_final_g):
    B, S = x.shape[0], x.shape[1]
    n_top = min(TOPK_MAX, S // 4)
    cos_h, sin_h = rope_tables(positions, ROT_DIM_HEAD)
    cos_i, sin_i = rope_tables(positions, ROT_DIM_IDX)

    for l in range(DEPTH):
        lam_init = 0.8 - 0.6 * math.exp(-0.3 * l)

        h = rmsnorm(x, norm_mix_g[l])
        proj = h @ w_in[l]
        (q_a, k_a, v_a, q_i, k_i, w_i, q_b, k_b, v_b, g) = split_columns(proj)

        q_a = apply_partial_rope(q_a.reshape(B, S, DSA_HEADS, HEAD_DIM), cos_h, sin_h)
        k_a = apply_partial_rope(k_a.reshape(B, S, DSA_HEADS, HEAD_DIM), cos_h, sin_h)
        v_a = v_a.reshape(B, S, DSA_HEADS, HEAD_DIM)
        q_i = apply_partial_rope(q_i.reshape(B, S, IDX_HEADS, IDX_DIM), cos_i, sin_i)
        k_i = layernorm(k_i, idx_k_norm_g[l], idx_k_norm_b[l])
        k_i = apply_partial_rope(k_i[:, :, None, :], cos_i, sin_i)[:, :, 0, :]
        o_a = dsa_sparse_attention(q_a, k_a, v_a, q_i, k_i, w_i, n_top)

        q_b = apply_partial_rope(q_b.reshape(B, S, 2 * DIFF_HEADS, DIFF_DIM), cos_h, sin_h)
        k_b = apply_partial_rope(k_b.reshape(B, S, 2 * DIFF_HEADS, DIFF_DIM), cos_h, sin_h)
        q_b = q_b.reshape(B, S, DIFF_HEADS, 2, DIFF_DIM)
        k_b = k_b.reshape(B, S, DIFF_HEADS, 2, DIFF_DIM)
        v_b = v_b.reshape(B, S, DIFF_HEADS, DIFF_VDIM)
        lam = (jnp.exp(jnp.sum(diff_lambda_q1[l] * diff_lambda_k1[l]).astype(jnp.float32))
               - jnp.exp(jnp.sum(diff_lambda_q2[l] * diff_lambda_k2[l]).astype(jnp.float32))
               + lam_init)
        o_b = differential_attention(q_b, k_b, v_b, lam)
        o_b = rmsnorm(o_b, diff_subln_g[l], eps=DIFF_SUBLN_EPS) * (1.0 - lam_init)
        o_b = o_b.reshape(B, S, DIFF_WIDTH)

        gates = jax.nn.sigmoid(g + gate_b[l]).reshape(B, S, N_BRANCH, D_MODEL)
        merged = (gates[:, :, 0] * (o_a @ w_branch_dsa[l])
                  + gates[:, :, 1] * (o_b @ w_branch_diff[l]))
        x = x + merged @ w_out[l]

        h = rmsnorm(x, norm_ffn_g[l])
        gu = h @ w_ffn_in[l]
        x = x + (jax.nn.silu(gu[..., :D_FF]) * gu[..., D_FF:]) @ w_ffn_out[l]

    return rmsnorm(x, norm_final_g)
```

```cpp
#include <hip/hip_runtime.h>
#include <hip/hip_cooperative_groups.h>
#include <cstdint>
#include <cstdio>

#define DI __device__ __forceinline__
typedef unsigned short bf16_t;
typedef short bf16x8 __attribute__((ext_vector_type(8)));
typedef float f32x16 __attribute__((ext_vector_type(16)));
typedef float f32x4 __attribute__((ext_vector_type(4)));
typedef unsigned u32x4 __attribute__((ext_vector_type(4)));
typedef unsigned long long u64;

constexpr int NB = 2, S = 8192, D = 1024, M = NB * S;
constexpr int NPROJ = 5632, DFF = 2816, NFF1 = 5632;
constexpr float C2 = 0.125f * 1.4426950408889634f;
constexpr float ROPE_THETA = 500000.0f;

constexpr size_t MiB = 1u << 20;
constexpr size_t WS_CTL = 0;
constexpr size_t WS_WT_IN = 1 * MiB, WS_WT_FF1 = 12 * MiB, WS_WT_FF2 = 23 * MiB, WS_WT_OUT = 29 * MiB, WS_WT_DSA = 31 * MiB, WS_WT_DIFF = 32 * MiB;
constexpr size_t WS_ROPE_H = 33 * MiB, WS_ROPE_I = 34 * MiB, WS_ROWSS1 = 34 * MiB + 512 * 1024;
constexpr size_t WS_XN = 36 * MiB, WS_MASK = 36 * MiB, WS_T = 36 * MiB;
constexpr size_t WS_QA = 68 * MiB, WS_KA = 84 * MiB, WS_VA = 100 * MiB, WS_QB = 116 * MiB, WS_KB = 132 * MiB, WS_VB = 148 * MiB;
constexpr size_t WS_QI = 164 * MiB, WS_KI = 172 * MiB, WS_WI = 173 * MiB;
constexpr size_t WS_G = 174 * MiB, WS_ROWSS2 = 238 * MiB;
constexpr size_t WS_MERGED = 84 * MiB, WS_X1B = 116 * MiB, WS_HF = 148 * MiB;
constexpr size_t WS_END = 256 * MiB;
constexpr size_t DO_OB1 = 0, DO_OBN = 32 * MiB;

DI int lane_id_asm() { int l; asm volatile("v_mbcnt_lo_u32_b32 %0, -1, 0\n\tv_mbcnt_hi_u32_b32 %0, -1, %0" : "=v"(l)); return l; }
DI float bf2f(bf16_t v) { return __uint_as_float((unsigned)v << 16); }
DI bf16_t f2bf(float f) { unsigned u = __float_as_uint(f); return (bf16_t)((u + 0x7fffu + ((u >> 16) & 1u)) >> 16); }
DI unsigned pk2(float lo, float hi) { return (unsigned)f2bf(lo) | ((unsigned)f2bf(hi) << 16); }
DI int crow(int r, int hi) { return (r & 3) + 8 * (r >> 2) + 4 * hi; }
DI float wave_sum(float v) {
#pragma unroll
    for (int o = 1; o < 64; o <<= 1) v += __shfl_xor(v, o);
    return v;
}
DI float wave_max(float v) {
#pragma unroll
    for (int o = 1; o < 64; o <<= 1) v = fmaxf(v, __shfl_xor(v, o));
    return v;
}
DI unsigned wave_sum_u(unsigned v) {
#pragma unroll
    for (int o = 1; o < 64; o <<= 1) v += __shfl_xor(v, o);
    return v;
}

DI int map_in(int v) {
    if (v < 1536) return v;
    if (v < 3072) return 1832 + (v - 1536);
    if (v < 3328) return 1536 + (v - 3072);
    if (v < 3360) return 1792 + (v - 3328);
    if (v < 3368) return 1824 + (v - 3360);
    if (v < 3584) return -1;
    return 3368 + (v - 3584);
}
DI int map_ff1(int v) { const int pn = v >> 8, o = v & 255; return (o < 128) ? (128 * pn + o) : (DFF + 128 * pn + (o - 128)); }

template <int MAPK> DI void transpose_item(const float* W, int K, int Nsrc, const float* gain, bf16_t* WT, int item, int nblk, float* scr, int lane) {
    const int kb = item / nblk, nb = item % nblk, k0 = 64 * kb, n0 = 32 * nb;
    const int v = n0 + (lane & 31);
    const int src = MAPK == 1 ? map_in(v) : (MAPK == 2 ? map_ff1(v) : v);
#pragma unroll 8
    for (int i = 0; i < 32; ++i) {
        const int kk = 2 * i + (lane >> 5);
        float x = (src >= 0) ? W[(size_t)(k0 + kk) * Nsrc + src] : 0.f;
        if (gain) x *= gain[k0 + kk];
        scr[kk * 33 + (lane & 31)] = x;
    }
    asm volatile("s_waitcnt lgkmcnt(0)" ::: "memory");
    const int c = lane & 7;
#pragma unroll
    for (int j = 0; j < 4; ++j) {
        const int n = (lane >> 3) + 8 * j; const float* s = scr + (8 * c) * 33 + n;
        u32x4 o; o.x = pk2(s[0 * 33], s[1 * 33]); o.y = pk2(s[2 * 33], s[3 * 33]); o.z = pk2(s[4 * 33], s[5 * 33]); o.w = pk2(s[6 * 33], s[7 * 33]);
        *(u32x4*)(WT + (size_t)(n0 + n) * K + k0 + 8 * c) = o;
    }
    asm volatile("s_waitcnt lgkmcnt(0)" ::: "memory");
}

struct PArgs {
    const float* in[19]; float* out; unsigned char* ws;
};

constexpr int IT_IN = 16 * 176, IT_FF1 = 16 * 176, IT_FF2 = 44 * 32, IT_OUT = 16 * 32, IT_DSA = 8 * 32, IT_DIFF = 8 * 32;
constexpr int IT_ALL = IT_IN + IT_FF1 + IT_FF2 + IT_OUT + IT_DSA + IT_DIFF;

__global__ void __launch_bounds__(64) nk_prologue(PArgs a) {
    __shared__ float scr[64 * 33];
    const int lane = threadIdx.x;
    const int gw = blockIdx.x, NGW = gridDim.x;
    unsigned char* ws = a.ws;
    for (int it = gw; it < IT_ALL; it += NGW) {
        int r = it;
        if (r < IT_IN) { transpose_item<1>(a.in[3], 1024, 5416, a.in[2], (bf16_t*)(ws + WS_WT_IN), r, 176, scr, lane); continue; } r -= IT_IN;
        if (r < IT_FF1) { transpose_item<2>(a.in[16], 1024, 5632, a.in[15], (bf16_t*)(ws + WS_WT_FF1), r, 176, scr, lane); continue; } r -= IT_FF1;
        if (r < IT_FF2) { transpose_item<0>(a.in[17], 2816, 1024, nullptr, (bf16_t*)(ws + WS_WT_FF2), r, 32, scr, lane); continue; } r -= IT_FF2;
        if (r < IT_OUT) { transpose_item<0>(a.in[14], 1024, 1024, nullptr, (bf16_t*)(ws + WS_WT_OUT), r, 32, scr, lane); continue; } r -= IT_OUT;
        if (r < IT_DSA) { transpose_item<0>(a.in[12], 512, 1024, nullptr, (bf16_t*)(ws + WS_WT_DSA), r, 32, scr, lane); continue; } r -= IT_DSA;
        transpose_item<0>(a.in[13], 512, 1024, nullptr, (bf16_t*)(ws + WS_WT_DIFF), r, 32, scr, lane);
    }
    const float* x = a.in[0]; const int* pos = (const int*)a.in[1];
    bf16_t* XN = (bf16_t*)(ws + WS_XN); float2* RH = (float2*)(ws + WS_ROPE_H); float2* RI = (float2*)(ws + WS_ROPE_I);
    for (int m = gw; m < M; m += NGW) {
        const f32x4* xr = (const f32x4*)(x + (size_t)m * D) + lane;
        f32x4 v[4]; float s = 0.f;
#pragma unroll
        for (int j = 0; j < 4; ++j) { v[j] = xr[64 * j]; s += (v[j].x * v[j].x + v[j].y * v[j].y) + (v[j].z * v[j].z + v[j].w * v[j].w); }
        const float rstd = 1.0f / sqrtf(wave_sum(s) * (1.f / D) + 1e-6f);
        u64* o8 = (u64*)(XN + (size_t)m * D) + lane;
#pragma unroll
        for (int j = 0; j < 4; ++j) o8[64 * j] = (u64)pk2(v[j].x * rstd, v[j].y * rstd) | ((u64)pk2(v[j].z * rstd, v[j].w * rstd) << 32);
        if (lane < 12) {
            const float p = (float)pos[m];
            const bool hd = lane < 8; const int j = hd ? lane : lane - 8;
            const float ex = hd ? -(float)(2 * j) / 16.0f : -(float)(2 * j) / 8.0f;
            const float inv = powf(ROPE_THETA, ex);
            const float ang = p * inv;
            float2 cs; cs.x = cosf(ang); cs.y = sinf(ang);
            if (hd) RH[(size_t)m * 8 + j] = cs; else RI[(size_t)m * 4 + j] = cs;
        }
    }
}

#define MFMA32(a, b, c) __builtin_amdgcn_mfma_f32_32x32x16_bf16((a), (b), (c), 0, 0, 0)
template <class Epi, bool DUAL>
__global__ void __launch_bounds__(256) ngemm_k(const bf16_t* A, int lda, const bf16_t* Bt, int ldb, int K, int ntn, Epi epi) {
    __shared__ float Cs[128][65];
    __shared__ float Cs2[DUAL ? 128 : 1][65];
    const int tile = blockIdx.x, tn = tile % ntn, tm = tile / ntn;
    const int tid = threadIdx.x, wid = tid >> 6, lane = tid & 63, r = lane & 31, h = lane >> 5;
    const int n0 = DUAL ? ((tn >> 1) * 256 + (tn & 1) * 64) : tn * 64;
    const int m0 = tm * 128 + wid * 32;
    f32x16 acc0 = {}, acc1 = {}, acc2 = {}, acc3 = {};
    const bf16_t* ap = A + (size_t)(m0 + r) * lda + 8 * h;
    const bf16_t* bp0 = Bt + (size_t)(n0 + r) * ldb + 8 * h;
    const bf16_t* bp1 = bp0 + (size_t)32 * ldb;
    const bf16_t* bp2 = bp0 + (size_t)128 * ldb;
    const bf16_t* bp3 = bp0 + (size_t)160 * ldb;
    for (int k = 0; k < K; k += 16) {
        const bf16x8 av = *(const bf16x8*)(ap + k), b0 = *(const bf16x8*)(bp0 + k), b1 = *(const bf16x8*)(bp1 + k);
        acc0 = MFMA32(av, b0, acc0); acc1 = MFMA32(av, b1, acc1);
        if (DUAL) { const bf16x8 b2 = *(const bf16x8*)(bp2 + k), b3 = *(const bf16x8*)(bp3 + k); acc2 = MFMA32(av, b2, acc2); acc3 = MFMA32(av, b3, acc3); }
    }
#pragma unroll
    for (int i = 0; i < 16; ++i) {
        const int rr = wid * 32 + crow(i, h);
        Cs[rr][r] = acc0[i]; Cs[rr][32 + r] = acc1[i];
        if (DUAL) { Cs2[rr][r] = acc2[i]; Cs2[rr][32 + r] = acc3[i]; }
    }
    __syncthreads();
    epi(tm * 128, n0, Cs, Cs2, tid);
}

struct NEpiIn {
    unsigned char* ws; const float* ki_g; const float* ki_b; const float* gate_b;
    DI void operator()(int m0, int n0, float (*Cs)[65], float (*)[65], int tid) const {
        const float2* RH = (const float2*)(ws + WS_ROPE_H); const float2* RI = (const float2*)(ws + WS_ROPE_I);
        if (n0 < 3072) {
            const int seg = n0 / 512, cb = n0 % 512;
            bf16_t* O = (bf16_t*)(ws + WS_QA + (size_t)seg * 16 * MiB);
            const bool rope = (seg % 3) != 2, isq = (seg % 3) == 0;
            for (int e = tid; e < 128 * 64; e += 256) {
                const int row = e >> 6, c = e & 63; float v = Cs[row][c];
                if (rope && c < 16) { const float2 cs = RH[(size_t)(m0 + row) * 8 + (c & 7)];
                    v = (c < 8) ? (v * cs.x - Cs[row][c + 8] * cs.y) : (v * cs.x + Cs[row][c - 8] * cs.y); }
                if (isq) v *= C2;
                O[(size_t)(m0 + row) * 512 + cb + c] = f2bf(v);
            }
        } else if (n0 < 3328) {
            bf16_t* O = (bf16_t*)(ws + WS_QI);
            for (int e = tid; e < 128 * 64; e += 256) {
                const int row = e >> 6, c = e & 63, c32 = c & 31; float v = Cs[row][c];
                if (c32 < 8) { const float2 cs = RI[(size_t)(m0 + row) * 4 + (c32 & 3)];
                    v = (c32 < 4) ? (v * cs.x - Cs[row][c + 4] * cs.y) : (v * cs.x + Cs[row][c - 4] * cs.y); }
                O[(size_t)(m0 + row) * 256 + (n0 - 3072) + c] = f2bf(v);
            }
        } else if (n0 == 3328) {
            bf16_t* KI = (bf16_t*)(ws + WS_KI); float* WI = (float*)(ws + WS_WI);
            for (int e = tid; e < 128 * 40; e += 256) {
                const int row = e / 40, c = e % 40;
                if (c < 32) {
                    float mu = 0.f; for (int j = 0; j < 32; ++j) mu += Cs[row][j]; mu *= (1.f / 32.f);
                    float var = 0.f; for (int j = 0; j < 32; ++j) { const float d = Cs[row][j] - mu; var += d * d; } var *= (1.f / 32.f);
                    const float rs = 1.0f / sqrtf(var + 1e-6f);
                    float v = (Cs[row][c] - mu) * rs * ki_g[c] + ki_b[c];
                    if (c < 8) { const int cp = (c < 4) ? c + 4 : c - 4; const float vp = (Cs[row][cp] - mu) * rs * ki_g[cp] + ki_b[cp];
                        const float2 cs = RI[(size_t)(m0 + row) * 4 + (c & 3)];
                        v = (c < 4) ? (v * cs.x - vp * cs.y) : (v * cs.x + vp * cs.y); }
                    KI[(size_t)(m0 + row) * 32 + c] = f2bf(v);
                } else WI[(size_t)(m0 + row) * 8 + (c - 32)] = Cs[row][c] * (1.0f / 16.0f);
            }
        } else if (n0 >= 3584) {
            bf16_t* G = (bf16_t*)(ws + WS_G);
            for (int e = tid; e < 128 * 64; e += 256) {
                const int row = e >> 6, c = e & 63, cg = n0 - 3584 + c;
                const float v = Cs[row][c] + gate_b[cg];
                G[(size_t)(m0 + row) * 2048 + cg] = f2bf(1.0f / (1.0f + __expf(-v)));
            }
        }
    }
};
template <int PASS> struct NEpiBranch {
    unsigned char* ws;
    DI void operator()(int m0, int n0, float (*Cs)[65], float (*)[65], int tid) const {
        const bf16_t* G = (const bf16_t*)(ws + WS_G); bf16_t* T = (bf16_t*)(ws + WS_T); bf16_t* MG = (bf16_t*)(ws + WS_MERGED);
        for (int e = tid; e < 128 * 64; e += 256) {
            const int row = e >> 6, c = e & 63; const size_t o = (size_t)(m0 + row) * 1024 + n0 + c;
            const float g = bf2f(G[(size_t)(m0 + row) * 2048 + (PASS - 1) * 1024 + n0 + c]);
            if (PASS == 1) T[o] = f2bf(g * Cs[row][c]); else MG[o] = f2bf(bf2f(T[o]) + g * Cs[row][c]);
        }
    }
};
struct NEpiOut {
    unsigned char* ws; const float* x; float* out;
    DI void operator()(int m0, int n0, float (*Cs)[65], float (*)[65], int tid) const {
        bf16_t* X1B = (bf16_t*)(ws + WS_X1B); float* RS = (float*)(ws + WS_ROWSS1);
        for (int e = tid; e < 128 * 64; e += 256) {
            const int row = e >> 6, c = e & 63; const size_t o = (size_t)(m0 + row) * 1024 + n0 + c;
            const float v = x[o] + Cs[row][c]; out[o] = v; X1B[o] = f2bf(v); Cs[row][c] = v;
        }
        __syncthreads();
        if (tid < 128) { float s = 0.f; for (int c = 0; c < 64; ++c) s += Cs[tid][c] * Cs[tid][c]; RS[(size_t)(m0 + tid) * 16 + (n0 >> 6)] = s; }
    }
};
DI float row_rstd(const float* RS, int row) { float s = 0.f; for (int i = 0; i < 16; ++i) s += RS[(size_t)row * 16 + i]; return 1.0f / sqrtf(s * (1.f / 1024.f) + 1e-6f); }
struct NEpiFF1 {
    unsigned char* ws;
    DI void operator()(int m0, int n0, float (*Cs)[65], float (*Cs2)[65], int tid) const {
        bf16_t* HF = (bf16_t*)(ws + WS_HF); const float* RS = (const float*)(ws + WS_ROWSS1);
        const int hc = (n0 >> 8) * 128 + (n0 & 255);
        for (int e = tid; e < 128 * 64; e += 256) {
            const int row = e >> 6, c = e & 63; const float rs = row_rstd(RS, m0 + row);
            const float g = Cs[row][c] * rs, u = Cs2[row][c] * rs;
            HF[(size_t)(m0 + row) * DFF + hc + c] = f2bf(g / (1.0f + __expf(-g)) * u);
        }
    }
};
struct NEpiFF2 {
    unsigned char* ws; float* out;
    DI void operator()(int m0, int n0, float (*Cs)[65], float (*)[65], int tid) const {
        float* RS = (float*)(ws + WS_ROWSS2);
        for (int e = tid; e < 128 * 64; e += 256) {
            const int row = e >> 6, c = e & 63; const size_t o = (size_t)(m0 + row) * 1024 + n0 + c;
            const float v = out[o] + Cs[row][c]; out[o] = v; Cs[row][c] = v;
        }
        __syncthreads();
        if (tid < 128) { float s = 0.f; for (int c = 0; c < 64; ++c) s += Cs[tid][c] * Cs[tid][c]; RS[(size_t)(m0 + tid) * 16 + (n0 >> 6)] = s; }
    }
};
__global__ void __launch_bounds__(256) nk_final(float* out, const float* RS, const float* g) {
    const int lane = threadIdx.x & 63, gw = blockIdx.x * 4 + (threadIdx.x >> 6), NGW = gridDim.x * 4;
    for (int m = gw; m < M; m += NGW) {
        const float rs = row_rstd(RS, m);
        f32x4* o = (f32x4*)(out + (size_t)m * D) + lane; const f32x4* gv = (const f32x4*)g + lane;
#pragma unroll
        for (int j = 0; j < 4; ++j) { f32x4 v = o[64 * j]; const f32x4 gg = gv[64 * j]; v = v * rs * gg; o[64 * j] = v; }
    }
}

DI unsigned fkey(float f) { const unsigned u = __float_as_uint(f); return (u & 0x80000000u) ? ~u : (u | 0x80000000u); }
__global__ void __launch_bounds__(256) nk_index(const bf16_t* QI, const bf16_t* KI, const float* WI, u64* MASK) {
    __shared__ unsigned su[8192];
    __shared__ unsigned short slist[8192];
    __shared__ float sq[256]; __shared__ float sw[8];
    __shared__ unsigned scnt, scnt2;
    const int tid = threadIdx.x, lane = tid & 63, wid = tid >> 6;
    for (int row = blockIdx.x; row < M; row += gridDim.x) {
        const int b = row / S, t = row % S, n = t + 1;
        sq[tid] = bf2f(QI[(size_t)row * 256 + tid]); if (tid < 8) sw[tid] = WI[(size_t)row * 8 + tid];
        __syncthreads();
        if (n <= 256) {
            if (tid < 128) { const int lo = 64 * tid; MASK[(size_t)row * 128 + tid] = (n - lo >= 64) ? ~0ull : (n > lo ? ((1ull << (n - lo)) - 1ull) : 0ull); }
            __syncthreads();
            continue;
        }
        for (int key = tid; key < n; key += 256) {
            const bf16x8* kp = (const bf16x8*)(KI + ((size_t)b * S + key) * 32);
            float kf[32];
#pragma unroll
            for (int c = 0; c < 4; ++c) { const bf16x8 v = kp[c];
#pragma unroll
                for (int j = 0; j < 8; ++j) kf[c * 8 + j] = bf2f((bf16_t)v[j]); }
            float sc = 0.f;
#pragma unroll
            for (int h = 0; h < 8; ++h) { float d = 0.f;
#pragma unroll
                for (int j = 0; j < 32; ++j) d += sq[h * 32 + j] * kf[j];
                sc += sw[h] * fmaxf(d, 0.f); }
            su[key] = fkey(sc);
        }
        __syncthreads();
        unsigned T = 0;
        for (int bit = 31; bit >= 0; --bit) {
            const unsigned cand = T | (1u << bit);
            if (tid == 0) scnt = 0;
            __syncthreads();
            unsigned c = 0; for (int key = tid; key < n; key += 256) c += (su[key] >= cand) ? 1u : 0u;
            c = wave_sum_u(c); if (lane == 0) atomicAdd(&scnt, c);
            __syncthreads();
            if (scnt >= 256u) T = cand;
            __syncthreads();
        }
        if (tid == 0) { scnt = 0; scnt2 = 0; }
        __syncthreads();
        { unsigned c = 0;
          for (int key = tid; key < n; key += 256) { const unsigned u = su[key]; if (u > T) ++c; else if (u == T) { const unsigned p = atomicAdd(&scnt2, 1u); slist[p] = (unsigned short)key; } }
          c = wave_sum_u(c); if (lane == 0) atomicAdd(&scnt, c); }
        __syncthreads();
        const int need = 256 - (int)scnt, mt = (int)scnt2;
        for (int i = tid; i < mt; i += 256) { const int idx = slist[i]; int rank = 0; for (int j = 0; j < mt; ++j) rank += (slist[j] < idx) ? 1 : 0; if (rank < need) su[idx] = 0xFFFFFFFFu; }
        __syncthreads();
        for (int c = wid; c < 128; c += 4) { const int key = 64 * c + lane; const bool sel = key < n && su[key] > T; const u64 bal = __ballot(sel); if (lane == 0) MASK[(size_t)row * 128 + c] = bal; }
        __syncthreads();
    }
}

__global__ void __launch_bounds__(64) nk_dsa(bf16_t* QAO, const bf16_t* KA, const bf16_t* VA, const u64* MASK) {
    __shared__ unsigned short slist[576]; __shared__ float sp[576]; __shared__ float sqh[64];
    const int lane = threadIdx.x;
    for (int row = blockIdx.x; row < M; row += gridDim.x) {
        const int b = row / S;
        u64 w0 = MASK[(size_t)row * 128 + lane], w1 = MASK[(size_t)row * 128 + 64 + lane];
        const int c0 = __popcll(w0), c1 = __popcll(w1);
        int i0 = c0, i1 = c1;
#pragma unroll
        for (int o = 1; o < 64; o <<= 1) { const int a0 = __shfl_up(i0, o), a1 = __shfl_up(i1, o); if (lane >= o) { i0 += a0; i1 += a1; } }
        const int tot0 = __shfl(i0, 63), tot1 = __shfl(i1, 63);
        int off0 = i0 - c0, off1 = tot0 + i1 - c1;
        int cnt = tot0 + tot1; if (cnt > 512) cnt = 512;
        while (w0) { const int bit = __ffsll((long long)w0) - 1; if (off0 < 512) slist[off0] = (unsigned short)(64 * lane + bit); ++off0; w0 &= w0 - 1; }
        while (w1) { const int bit = __ffsll((long long)w1) - 1; if (off1 < 512) slist[off1] = (unsigned short)(64 * (64 + lane) + bit); ++off1; w1 &= w1 - 1; }
        __syncthreads();
        for (int h = 0; h < 8; ++h) {
            sqh[lane] = bf2f(QAO[(size_t)row * 512 + h * 64 + lane]);
            __syncthreads();
            float mx = -INFINITY;
            for (int i = lane; i < cnt; i += 64) {
                const int key = slist[i]; const bf16x8* kp = (const bf16x8*)(KA + ((size_t)b * S + key) * 512 + h * 64);
                float s = 0.f;
#pragma unroll
                for (int c = 0; c < 8; ++c) { const bf16x8 v = kp[c];
#pragma unroll
                    for (int j = 0; j < 8; ++j) s += sqh[c * 8 + j] * bf2f((bf16_t)v[j]); }
                sp[i] = s; mx = fmaxf(mx, s);
            }
            mx = wave_max(mx);
            float l = 0.f;
            for (int i = lane; i < cnt; i += 64) { const float p = exp2f(sp[i] - mx); sp[i] = p; l += p; }
            l = wave_sum(l);
            __syncthreads();
            float o = 0.f;
            for (int i = 0; i < cnt; ++i) { const int key = slist[i]; o += sp[i] * bf2f(VA[((size_t)b * S + key) * 512 + h * 64 + lane]); }
            o /= l;
            __syncthreads();
            QAO[(size_t)row * 512 + h * 64 + lane] = f2bf(o);
        }
        __syncthreads();
    }
}

__global__ void __launch_bounds__(256) nk_diff(const bf16_t* QB, const bf16_t* KB, const bf16_t* VB, bf16_t* OB1) {
    __shared__ float Ks[32][64]; __shared__ float Vs[32][128];
    const int blk = blockIdx.x, qb = 63 - (blk & 63), hm = (blk >> 6) & 7, b = blk >> 9, h = hm >> 1;
    const int tid = threadIdx.x, qr = tid & 127, vh = tid >> 7;
    const int t = qb * 128 + qr; const size_t row = (size_t)b * S + t;
    float q[64], o[64];
    { const bf16x8* qp = (const bf16x8*)(QB + row * 512 + hm * 64);
#pragma unroll
      for (int c = 0; c < 8; ++c) { const bf16x8 v = qp[c];
#pragma unroll
          for (int j = 0; j < 8; ++j) q[c * 8 + j] = bf2f((bf16_t)v[j]); } }
#pragma unroll
    for (int d = 0; d < 64; ++d) o[d] = 0.f;
    float m = -INFINITY, l = 0.f;
    const int ntile = (qb * 128 + 128) / 32;
    for (int kt = 0; kt < ntile; ++kt) {
        __syncthreads();
        { const size_t kr = (size_t)b * S + kt * 32 + (tid >> 3);
          const bf16x8 v = *(const bf16x8*)(KB + kr * 512 + hm * 64 + (tid & 7) * 8);
#pragma unroll
          for (int j = 0; j < 8; ++j) Ks[tid >> 3][(tid & 7) * 8 + j] = bf2f((bf16_t)v[j]);
          const bf16x8* vp = (const bf16x8*)(VB + kr * 512 + h * 128 + (tid & 7) * 16);
          const bf16x8 v0 = vp[0], v1 = vp[1];
#pragma unroll
          for (int j = 0; j < 8; ++j) { Vs[tid >> 3][(tid & 7) * 16 + j] = bf2f((bf16_t)v0[j]); Vs[tid >> 3][(tid & 7) * 16 + 8 + j] = bf2f((bf16_t)v1[j]); } }
        __syncthreads();
        float s[32]; float tm = -INFINITY;
#pragma unroll
        for (int j = 0; j < 32; ++j) {
            float a = 0.f;
#pragma unroll
            for (int d = 0; d < 64; ++d) a += q[d] * Ks[j][d];
            if (kt * 32 + j > t) a = -INFINITY;
            s[j] = a; tm = fmaxf(tm, a);
        }
        const float mn = fmaxf(m, tm);
        const float sc = exp2f(m - mn);
        l *= sc;
#pragma unroll
        for (int d = 0; d < 64; ++d) o[d] *= sc;
        m = mn;
#pragma unroll
        for (int j = 0; j < 32; ++j) {
            const float p = exp2f(s[j] - m); l += p;
#pragma unroll
            for (int d = 0; d < 64; ++d) o[d] += p * Vs[j][vh * 64 + d];
        }
    }
    const float inv = 1.0f / l;
    bf16_t* op = OB1 + row * 1024 + hm * 128 + vh * 64;
#pragma unroll
    for (int d = 0; d < 64; ++d) op[d] = f2bf(o[d] * inv);
}
__global__ void __launch_bounds__(256) nk_diff_combine(const bf16_t* OB1, bf16_t* OBN, const float* lq1, const float* lk1, const float* lq2, const float* lk2, const float* g) {
    const int lane = threadIdx.x & 63, gw = blockIdx.x * 4 + (threadIdx.x >> 6), NGW = gridDim.x * 4;
    const float s1 = wave_sum(lq1[lane] * lk1[lane]), s2 = wave_sum(lq2[lane] * lk2[lane]);
    const float lam = expf(s1) - expf(s2) + 0.2f;
    const float g0 = g[2 * lane], g1 = g[2 * lane + 1];
    for (int m = gw; m < M; m += NGW) {
#pragma unroll
        for (int h = 0; h < 4; ++h) {
            const unsigned a = *(const unsigned*)(OB1 + (size_t)m * 1024 + (2 * h) * 128 + 2 * lane);
            const unsigned c = *(const unsigned*)(OB1 + (size_t)m * 1024 + (2 * h + 1) * 128 + 2 * lane);
            const float v0 = bf2f((bf16_t)(a & 0xffff)) - lam * bf2f((bf16_t)(c & 0xffff)), v1 = bf2f((bf16_t)(a >> 16)) - lam * bf2f((bf16_t)(c >> 16));
            const float ss = wave_sum(v0 * v0 + v1 * v1);
            const float rs = 0.8f / sqrtf(ss * (1.f / 128.f) + 1e-5f);
            *(unsigned*)(OBN + (size_t)m * 512 + h * 128 + 2 * lane) = pk2(v0 * rs * g0, v1 * rs * g1);
        }
    }
}

namespace pg8 {
#define PG8_LAS __attribute__((address_space(3)))
typedef unsigned short bf16_t;
typedef short bf16x8 __attribute__((ext_vector_type(8)));
typedef float f32x4 __attribute__((ext_vector_type(4)));
typedef unsigned u32x4 __attribute__((ext_vector_type(4)));
constexpr int BM = 256, BK = 64, HALF = 128, HTB = HALF * BK * 2  , STAGE_BYTES = 8 * HTB, NXCD = 8, WGM = 8;

__host__ __device__ __forceinline__ int lds_byte(int r, int c) { const int st = (r >> 4) * 2 + (c >> 5), rr = r & 15, cc = c & 31, ob = rr * 64 + cc * 2; return st * 1024 + (ob ^ (((ob >> 9) & 1) << 5)); }
__host__ __device__ __forceinline__ void stage_rc(int b, int& R, int& C) { const int st = b / 1024, sb = b % 1024, swz = sb ^ (((sb >> 9) & 1) << 5); R = (st >> 1) * 16 + swz / 64; C = (st & 1) * 32 + (swz % 64) / 2; }
__host__ __device__ __forceinline__ int perm32(int rho) { const int n = rho >> 4, i = rho & 15; return 8 * (i >> 2) + 4 * n + (i & 3); }

struct Unit { int pm, pn; };
struct Gemm { const bf16_t* A; const bf16_t* Bt; int M, N, K; };

struct StaticOrder {
    int nM, nN, nwg, G, c;
    __host__ __device__ void init(int M, int N, int G_, int c_) { nM = M / BM; nN = N / BM; nwg = nM * nN; G = G_; c = c_; }
    __host__ __device__ bool next(int i, Unit& u) const {
        const long L = (long)i * G + c; if (L >= nwg) return false;
        int wgid = (int)L; { const int q = nwg / NXCD, r = nwg % NXCD, xcd = wgid % NXCD, off = wgid / NXCD; wgid = (xcd < r ? xcd * (q + 1) : r * (q + 1) + (xcd - r) * q) + off; }
        const int nig = WGM * nN, gid = wgid / nig, fm = gid * WGM, gsz = (nM - fm) < WGM ? (nM - fm) : WGM;
        u.pm = fm + ((wgid % nig) % gsz); u.pn = (wgid % nig) / gsz; return true;
    }
    __device__ __forceinline__ void a_ready(const Unit&) const {}
    __device__ __forceinline__ void done(const Unit&) const {}
};

__device__ __forceinline__ unsigned cvt_pk_bf16(float lo, float hi) { unsigned r; asm volatile("v_cvt_pk_bf16_f32 %0, %1, %2" : "=v"(r) : "v"(lo), "v"(hi)); return r; }
template <class Epi, class Sched, bool ALIGN_EPI = false, bool SP2 = false>
__device__ __forceinline__ void gemm_phase(PG8_LAS unsigned char* lds, const Gemm g, const Sched& S, const Epi& E, const int wid_s) {
    const int tid = wid_s * 64 + lane_id_asm(), wid = wid_s, lane = tid & 63, wr = wid >> 2, wc = wid & 3, fr = lane & 15, fq = lane >> 4;
    const int K = g.K, nt = K / BK;
    unsigned voffA[2], voffB[2];
#pragma unroll
    for (int i = 0; i < 2; ++i) { int R, C; stage_rc(tid * 16 + i * 8192, R, C); const int Rb = Epi::PERM ? ((R & ~31) + perm32(R & 31)) : R;
        voffA[i] = (unsigned)(R * K + C) * 2u; voffB[i] = (unsigned)(Rb * K + C) * 2u; }
    const size_t kstep = (size_t)(BK * 2);
    const size_t hstep = (size_t)HALF * K * 2;
    const size_t tstep = 2 * hstep;
    const unsigned ldsw = (unsigned)wid * 1024u;
    const int aoff = lds_byte(wr * 64 + fr, fq * 8), boff = lds_byte(wc * 32 + fr, fq * 8);
#define PG8_SA(b, h) (((b) * 2 + (h)) * HTB)
#define PG8_SB(b, h) ((4 + (b) * 2 + (h)) * HTB)
#define PG8_STAGE(bufoff, gbase, voff) do { _Pragma("unroll") for (int _i = 0; _i < 2; ++_i) \
        __builtin_amdgcn_global_load_lds((const unsigned*)((const char*)(gbase) + (voff)[_i]), (PG8_LAS unsigned*)(lds + (bufoff) + ldsw + _i * 8192), 16, 0, 0); } while (0)
#define PG8_LDA(dst, b, h) do { _Pragma("unroll") for (int m = 0; m < 4; ++m) _Pragma("unroll") for (int k = 0; k < 2; ++k) dst[m][k] = *(const PG8_LAS bf16x8*)(lds + PG8_SA(b, h) + aoff + m * 2048 + k * 1024); } while (0)
#define PG8_LDB(dst, b, h) do { _Pragma("unroll") for (int n = 0; n < 2; ++n) _Pragma("unroll") for (int k = 0; k < 2; ++k) dst[n][k] = *(const PG8_LAS bf16x8*)(lds + PG8_SB(b, h) + boff + n * 2048 + k * 1024); } while (0)
#define PG8_MMA(ai, bj, At, Bt) do { __builtin_amdgcn_s_setprio(1); _Pragma("unroll") for (int m = 0; m < 4; ++m) _Pragma("unroll") for (int n = 0; n < 2; ++n) _Pragma("unroll") for (int k = 0; k < 2; ++k) \
        acc[ai][bj][m][n] = __builtin_amdgcn_mfma_f32_16x16x32_bf16(Bt[n][k], At[m][k], acc[ai][bj][m][n], 0, 0, 0); __builtin_amdgcn_s_setprio(0); } while (0)
#define PG8_WAIT_V(n) asm volatile("s_waitcnt vmcnt(" #n ")" ::: "memory")
#define PG8_WAIT_L(n) asm volatile("s_waitcnt lgkmcnt(" #n ")" ::: "memory")
#define PG8_BAR __builtin_amdgcn_s_barrier()
#define PG8_SCHED __builtin_amdgcn_sched_barrier(0)
    Unit cur, nxt; int ui = 0;
    if (!S.next(0, cur)) return;
    f32x4 acc[2][2][4][2];
#pragma unroll
    for (int a = 0; a < 2; ++a)
#pragma unroll
        for (int b = 0; b < 2; ++b)
#pragma unroll
            for (int m = 0; m < 4; ++m)
#pragma unroll
                for (int n = 0; n < 2; ++n) acc[a][b][m][n] = (f32x4){0.f, 0.f, 0.f, 0.f};
    bf16x8 At[4][2], B0[2][2], B1[2][2];
    const char* cA = (const char*)g.A + (size_t)cur.pm * tstep; const char* cB = (const char*)g.Bt + (size_t)cur.pn * tstep;
    S.a_ready(cur);
    if constexpr (SP2) {
        PG8_STAGE(PG8_SB(0, 0), cB, voffB); PG8_STAGE(PG8_SB(0, 1), cB + hstep, voffB); PG8_STAGE(PG8_SA(0, 0), cA, voffA); PG8_STAGE(PG8_SA(0, 1), cA + hstep, voffA);
        if (wr == 1) PG8_BAR;
        PG8_WAIT_V(2); PG8_BAR;
        PG8_STAGE(PG8_SB(1, 0), cB + kstep, voffB); PG8_STAGE(PG8_SA(1, 0), cA + kstep, voffA); PG8_STAGE(PG8_SB(1, 1), cB + hstep + kstep, voffB);
        PG8_WAIT_V(6); PG8_BAR;
    } else {
        PG8_STAGE(PG8_SB(0, 0), cB, voffB); PG8_STAGE(PG8_SA(0, 0), cA, voffA); PG8_STAGE(PG8_SB(0, 1), cB + hstep, voffB); PG8_STAGE(PG8_SA(0, 1), cA + hstep, voffA);
        if (wr == 1) PG8_BAR;
        PG8_WAIT_V(4); PG8_BAR;
        PG8_STAGE(PG8_SB(1, 0), cB + kstep, voffB); PG8_STAGE(PG8_SA(1, 0), cA + kstep, voffA); PG8_STAGE(PG8_SB(1, 1), cB + hstep + kstep, voffB);
        PG8_WAIT_V(6); PG8_BAR;
    }
    for (;;) {
        const bool has_next = S.next(ui + 1, nxt);
        const char* nA = has_next ? (const char*)g.A + (size_t)nxt.pm * tstep : cA; const char* nB = has_next ? (const char*)g.Bt + (size_t)nxt.pn * tstep : cB;
        for (int t = 0; t < nt; t += 2) {
            const bool last = (t == nt - 2);
            const char* a1 = cA + (size_t)(t + 1) * kstep;
            const char* a2 = last ? nA : cA + (size_t)(t + 2) * kstep; const char* b2 = last ? nB : cB + (size_t)(t + 2) * kstep;
            const char* a3 = a2 + kstep; const char* b3 = b2 + kstep;
            if (last && has_next) S.a_ready(nxt);
            if constexpr (SP2) {
            PG8_LDB(B0, 0, 0); PG8_LDB(B1, 0, 1); PG8_SCHED; PG8_LDA(At, 0, 0); PG8_STAGE(PG8_SA(1, 1), a1 + hstep, voffA);
            PG8_WAIT_V(8); PG8_WAIT_L(0); PG8_BAR; PG8_MMA(0, 0, At, B0); PG8_MMA(0, 1, At, B1); PG8_BAR; PG8_SCHED;
            PG8_LDA(At, 0, 1); PG8_STAGE(PG8_SB(0, 0), b2, voffB); PG8_STAGE(PG8_SB(0, 1), b2 + hstep, voffB); PG8_STAGE(PG8_SA(0, 0), a2, voffA);
            PG8_WAIT_V(8); PG8_WAIT_L(0); PG8_BAR; PG8_MMA(1, 0, At, B0); PG8_MMA(1, 1, At, B1); PG8_BAR; PG8_SCHED;
            PG8_LDB(B0, 1, 0); PG8_LDB(B1, 1, 1); PG8_SCHED; PG8_LDA(At, 1, 0); PG8_STAGE(PG8_SA(0, 1), a2 + hstep, voffA);
            PG8_WAIT_V(8); PG8_WAIT_L(0); PG8_BAR; PG8_MMA(0, 0, At, B0); PG8_MMA(0, 1, At, B1); PG8_BAR; PG8_SCHED;
            PG8_LDA(At, 1, 1); PG8_STAGE(PG8_SB(1, 0), b3, voffB); PG8_STAGE(PG8_SB(1, 1), b3 + hstep, voffB); PG8_STAGE(PG8_SA(1, 0), a3, voffA);
            PG8_WAIT_V(8); PG8_WAIT_L(0); PG8_BAR; PG8_MMA(1, 0, At, B0); PG8_MMA(1, 1, At, B1); PG8_BAR; PG8_SCHED;
            } else {
            PG8_LDB(B0, 0, 0); PG8_SCHED; PG8_LDA(At, 0, 0); PG8_STAGE(PG8_SA(1, 1), a1 + hstep, voffA);
            PG8_WAIT_L(8); PG8_BAR; PG8_WAIT_L(0); PG8_MMA(0, 0, At, B0); PG8_BAR; PG8_SCHED;
            PG8_LDB(B1, 0, 1); PG8_STAGE(PG8_SB(0, 0), b2, voffB);
            PG8_BAR; PG8_WAIT_L(0); PG8_MMA(0, 1, At, B1); PG8_BAR;
            PG8_LDA(At, 0, 1); PG8_STAGE(PG8_SA(0, 0), a2, voffA);
            PG8_BAR; PG8_WAIT_L(0); PG8_MMA(1, 0, At, B0); PG8_BAR; PG8_SCHED;
            PG8_STAGE(PG8_SB(0, 1), b2 + hstep, voffB);
            PG8_WAIT_V(6); PG8_BAR; PG8_MMA(1, 1, At, B1); PG8_BAR;
            PG8_LDB(B0, 1, 0); PG8_SCHED; PG8_LDA(At, 1, 0); PG8_STAGE(PG8_SA(0, 1), a2 + hstep, voffA);
            PG8_WAIT_L(8); PG8_BAR; PG8_WAIT_L(0); PG8_MMA(0, 0, At, B0); PG8_BAR; PG8_SCHED;
            PG8_LDB(B1, 1, 1); PG8_STAGE(PG8_SB(1, 0), b3, voffB);
            PG8_BAR; PG8_WAIT_L(0); PG8_MMA(0, 1, At, B1); PG8_BAR;
            PG8_LDA(At, 1, 1); PG8_STAGE(PG8_SA(1, 0), a3, voffA);
            PG8_BAR; PG8_WAIT_L(0); PG8_MMA(1, 0, At, B0); PG8_BAR; PG8_SCHED;
            PG8_STAGE(PG8_SB(1, 1), b3 + hstep, voffB);
            PG8_WAIT_V(6); PG8_BAR; PG8_MMA(1, 1, At, B1); PG8_BAR;
            }
        }
        if constexpr (ALIGN_EPI) { if (wr == 0) PG8_BAR; }
        if constexpr (!Epi::AFTER_DRAIN) { E(acc, cur, wr, wc, fr, fq); S.done(cur); __builtin_amdgcn_s_waitcnt(0x0F70);   }
        if (!has_next) break;
#pragma unroll
        for (int a = 0; a < 2; ++a)
#pragma unroll
            for (int b = 0; b < 2; ++b)
#pragma unroll
                for (int m = 0; m < 4; ++m)
#pragma unroll
                    for (int n = 0; n < 2; ++n) acc[a][b][m][n] = (f32x4){0.f, 0.f, 0.f, 0.f};
        cur = nxt; cA = nA; cB = nB; ++ui;
        if constexpr (ALIGN_EPI) { if (wr == 1) PG8_BAR; }
    }
    PG8_WAIT_V(0);
    if constexpr (!ALIGN_EPI) { if (wr == 0) PG8_BAR; }
    PG8_BAR;
    if constexpr (Epi::AFTER_DRAIN) { E.fused(acc, cur, wr, wc, fr, fq, lds, wid, lane); S.done(cur); }
#undef PG8_SA
#undef PG8_SB
#undef PG8_STAGE
#undef PG8_LDA
#undef PG8_LDB
#undef PG8_MMA
#undef PG8_WAIT_V
#undef PG8_WAIT_L
#undef PG8_BAR
#undef PG8_SCHED
}
}
#include <hip/hip_bf16.h>
#include <cmath>
namespace attn_body {
using bf16=__hip_bfloat16;
using bf16x8=__attribute__((ext_vector_type(8)))short;
using s16x4=__attribute__((ext_vector_type(4)))short;
using f32x16=__attribute__((ext_vector_type(16)))float;
using u32x4=__attribute__((ext_vector_type(4)))unsigned;
constexpr int BATCH=2,NHEAD=16,SEQ=8192,D=64,DM=NHEAD*D;
constexpr int NW=8,QBLK=32,QB=QBLK*NW,KVBLK=64,NQB=SEQ/QB;
constexpr int ATTN_PITCH=DM, ATTN_UNIT_ROWS=QB;
__device__ __forceinline__ int crow(int r,int hi){return (r&3)+8*(r>>2)+4*hi;}
#define SBAR() __builtin_amdgcn_sched_barrier(0)
__device__ __forceinline__ void cmask(f32x16&p0,f32x16&p1,int jb,int qrel,int hi){
  const float NEG=-INFINITY; int kb=64*jb+4*hi;
  #pragma unroll
  for(int r=0;r<16;++r){int kv=kb+(r&3)+8*(r>>2); if(kv>qrel)p0[r]=NEG; if(kv+32>qrel)p1[r]=NEG;}
}

constexpr int NSLOT=3, SLOTB=8192;
constexpr int LDS_K=0, LDS_V=NSLOT*SLOTB, LDS_WS=2*NSLOT*SLOTB, LDS_OST=LDS_WS+NW*64*4, LDS_BYTES=LDS_OST+NW*4096;
constexpr float C2=0.125f*1.4426950408889634f;
__device__ __forceinline__ void glds16(const void*gsrc,unsigned lds_dst){unsigned keep;
  asm volatile("s_mov_b32 %0, m0\n\ts_mov_b32 m0, %2\n\ts_nop 0\n\tglobal_load_lds_dwordx4 %1, off\n\ts_mov_b32 m0, %0":"=&s"(keep):"v"(gsrc),"s"(lds_dst):"memory");}
__device__ __forceinline__ float max3f(float a,float b,float c){float r;asm("v_max3_f32 %0, %1, %2, %3":"=v"(r):"v"(a),"v"(b),"v"(c));return r;}
__device__ __forceinline__ float max2f(float a,float b){float r;asm("v_max_f32_e32 %0, %1, %2":"=v"(r):"v"(a),"v"(b));return r;}
__device__ __forceinline__ float fadd_s(float a,float b){float r;asm("v_add_f32_e32 %0, %1, %2":"=v"(r):"v"(a),"v"(b));return r;}
__device__ __forceinline__ float fsub_s(float a,float b){float r;asm("v_sub_f32_e32 %0, %1, %2":"=v"(r):"v"(a),"v"(b));return r;}
typedef float f32x2_t __attribute__((ext_vector_type(2))); typedef __bf16 bf16x2_t __attribute__((ext_vector_type(2)));
__device__ __forceinline__ unsigned cvtpk_s(float lo,float hi){f32x2_t v={lo,hi};bf16x2_t b=__builtin_convertvector(v,bf16x2_t);return __builtin_bit_cast(unsigned,b);}
#define WAIT_BAR(N) asm volatile("s_waitcnt vmcnt(" #N ") lgkmcnt(0)\n\ts_barrier":::"memory")

__device__ __forceinline__ void qkt(f32x16&p0,f32x16&p1,const char*Kslot,const bf16x8*qr,const f32x16&negm,int r32,int hi){
  const char*kb=Kslot+hi*1024+r32*16;
  #pragma unroll
  for(int d0=0;d0<4;++d0){
    const bf16x8 b0=*reinterpret_cast<const bf16x8*>(kb+d0*2048);
    const bf16x8 b1=*reinterpret_cast<const bf16x8*>(kb+d0*2048+512);
    if(d0==0){p0=__builtin_amdgcn_mfma_f32_32x32x16_bf16(b0,qr[0],negm,0,0,0);p1=__builtin_amdgcn_mfma_f32_32x32x16_bf16(b1,qr[0],negm,0,0,0);}
    else{p0=__builtin_amdgcn_mfma_f32_32x32x16_bf16(b0,qr[d0],p0,0,0,0);p1=__builtin_amdgcn_mfma_f32_32x32x16_bf16(b1,qr[d0],p1,0,0,0);}}
}
typedef __attribute__((address_space(3))) const char* lds_cptr;
typedef short v4i16_t __attribute__((ext_vector_type(4)));
__device__ __forceinline__ void kload8(bf16x8*kf,lds_cptr kp){
  kf[0]=*(const __attribute__((address_space(3))) bf16x8*)(kp);      kf[1]=*(const __attribute__((address_space(3))) bf16x8*)(kp+512);
  kf[2]=*(const __attribute__((address_space(3))) bf16x8*)(kp+2048); kf[3]=*(const __attribute__((address_space(3))) bf16x8*)(kp+2560);
  kf[4]=*(const __attribute__((address_space(3))) bf16x8*)(kp+4096); kf[5]=*(const __attribute__((address_space(3))) bf16x8*)(kp+4608);
  kf[6]=*(const __attribute__((address_space(3))) bf16x8*)(kp+6144); kf[7]=*(const __attribute__((address_space(3))) bf16x8*)(kp+6656);
}
__device__ __forceinline__ void kload2(bf16x8*kf,lds_cptr kp,int j){ kf[2*j]=*(const __attribute__((address_space(3))) bf16x8*)(kp+j*2048); kf[2*j+1]=*(const __attribute__((address_space(3))) bf16x8*)(kp+j*2048+512); }
__device__ __forceinline__ s16x4 vtr(lds_cptr p){ return __builtin_bit_cast(s16x4,__builtin_amdgcn_ds_read_tr16_b64_v4i16((__attribute__((address_space(3))) v4i16_t*)p)); }
__device__ __forceinline__ float rowmax(const f32x16&p0,const f32x16&p1){
  float a=max3f(p0[0],p0[1],p1[0]),b=max3f(p0[2],p0[3],p1[1]);a=max3f(a,p1[2],p1[3]);
  #pragma unroll
  for(int r=4;r<16;r+=4){a=max3f(a,p0[r],p0[r+1]);b=max3f(b,p0[r+2],p0[r+3]);a=max3f(a,p1[r],p1[r+1]);b=max3f(b,p1[r+2],p1[r+3]);}
  const float m=max2f(a,b);
  auto rr=__builtin_amdgcn_permlane32_swap(__float_as_uint(m),__float_as_uint(m),false,false);
  return max2f(__uint_as_float(rr[0]),__uint_as_float(rr[1]));
}
__device__ __forceinline__ void pv(f32x16*o,int vb,bf16x8 pa0,bf16x8 pa1,bf16x8 pa2,bf16x8 pa3){
  #pragma unroll
  for(int d0=0;d0<2;++d0){s16x4 lo[4],hi[4];
    #pragma unroll
    for(int ks=0;ks<4;++ks){
      asm volatile("ds_read_b64_tr_b16 %0,%1 offset:%c2":"=&v"(lo[ks]):"v"(vb),"i"(d0*4096+ks*1024):"memory");
      asm volatile("ds_read_b64_tr_b16 %0,%1 offset:%c2":"=&v"(hi[ks]):"v"(vb),"i"(d0*4096+ks*1024+512):"memory");}
    asm volatile("s_waitcnt lgkmcnt(0)":::"memory");SBAR();
    #define PK(k) (bf16x8){lo[k][0],lo[k][1],lo[k][2],lo[k][3],hi[k][0],hi[k][1],hi[k][2],hi[k][3]}
    o[d0]=__builtin_amdgcn_mfma_f32_32x32x16_bf16(pa0,PK(0),o[d0],0,0,0);
    o[d0]=__builtin_amdgcn_mfma_f32_32x32x16_bf16(pa1,PK(1),o[d0],0,0,0);
    o[d0]=__builtin_amdgcn_mfma_f32_32x32x16_bf16(pa2,PK(2),o[d0],0,0,0);
    o[d0]=__builtin_amdgcn_mfma_f32_32x32x16_bf16(pa3,PK(3),o[d0],0,0,0);
    #undef PK
  }
}

__device__ __forceinline__ float mand(float x,unsigned w,int c){ const int m=((int)(w<<(31-c)))>>31; return __int_as_float(__float_as_int(x)&m); }
#define MBIT(r) (((r)&3)+8*((r)>>2))
#ifndef ATTN_STORE16
#define ATTN_STORE16(p,v) (*(u32x4*)(p)=(v))
#endif
template<int THRL,int QP,int KP,int VP,int OP,bool MASKED> __device__ __forceinline__ void attn_unit(int b,int qb,const bf16*Q,const bf16*__restrict__ K,const bf16*__restrict__ V,bf16*O,const unsigned long long*MK,char*shm,const int wid_s){
  const int lane=lane_id_asm(),tid=wid_s*64+lane,r32=lane&31,hi=lane>>5; const int wid=wid_s; (void)tid;
  const long rowbase=(long)b*SEQ; const int q0=qb*QB;
  const bf16*Qw=Q+(rowbase+q0+wid*QBLK)*QP;
  const bf16*Kh=K+rowbase*KP,*Vh=V+rowbase*VP;
  const unsigned lds0=(unsigned)(uintptr_t)shm;
  float*wsf=(float*)(shm+LDS_WS)+wid*64;
  const bf16*ksrc=Kh+(long)lane*KP+wid*8;
  const bf16*vsrc=Vh+(long)(16*(wid&3)+(lane>>2))*VP+(wid>>2)*32+(lane&3)*8;
  const unsigned kdst=lds0+LDS_K+wid*1024, vdst=lds0+LDS_V+wid*1024;
  #define DMA_K(t,slot) glds16(ksrc+(long)(t)*KVBLK*KP,(unsigned)__builtin_amdgcn_readfirstlane(kdst+(slot)))
  #define DMA_V(t,slot) glds16(vsrc+(long)(t)*KVBLK*VP,(unsigned)__builtin_amdgcn_readfirstlane(vdst+(slot)))
  const int vb0=(int)(lds0+LDS_V)+((lane>>4)&1)*32+(lane&3)*8+(4*hi+((lane&15)>>2))*64;
  const char*Kbase=shm+LDS_K; bf16x8 kf[8];
  const lds_cptr shm3=(lds_cptr)shm; const lds_cptr kp0=shm3+LDS_K+hi*1024+r32*16; const lds_cptr vp0=shm3+LDS_V+((lane>>4)&1)*32+(lane&3)*8+(4*hi+((lane&15)>>2))*64;
  const int NT=(q0+QB)/KVBLK;
  DMA_K(0,0);DMA_V(0,0);DMA_K(1,SLOTB);
  const unsigned long long*mkw=MK+((rowbase+q0+wid*QBLK)<<7);
  const unsigned long long*mkp=mkw+(r32<<7);
  unsigned mlo=0u,mhi=0u,nlo=0u,nhi=0u;
  if(MASKED){ const unsigned long long w0=mkp[0],w1=mkp[1]; mlo=(unsigned)w0>>(4*hi); mhi=(unsigned)(w0>>32)>>(4*hi); nlo=(unsigned)w1>>(4*hi); nhi=(unsigned)(w1>>32)>>(4*hi); }
  bf16x8 qr[4];
  #pragma unroll
  for(int d0=0;d0<4;++d0)qr[d0]=*reinterpret_cast<const bf16x8*>(&Qw[(long)r32*QP+d0*16+hi*8]);
  float zf_; asm volatile("v_mov_b32 %0, 0":"=v"(zf_));
  float mhat=zf_,l_reg=zf_;f32x16 o[2];
  _Pragma("unroll") for(int r=0;r<16;++r){o[0][r]=zf_;o[1][r]=zf_;}
  f32x16 negm; _Pragma("unroll") for(int r=0;r<16;++r)negm[r]=zf_; asm volatile("":"+v"(negm));
  const int qrel=wid*QBLK+r32;
  #define CMASK(P0,P1,t) do{ if(!MASKED){ int jb_=(t)-(NT-4); if(jb_>=0)cmask(P0,P1,jb_,qrel,hi);} }while(0)
  bool resc=false;
  #define START(P0,P1) do{ const float rm=rowmax(P0,P1); resc=false; \
    { const float dl=rm; mhat=fadd_s(mhat,dl); \
      _Pragma("unroll") for(int r=0;r<16;++r){P0[r]=fsub_s(P0[r],dl);P1[r]=fsub_s(P1[r],dl);} \
      _Pragma("unroll") for(int r=0;r<16;++r)negm[r]=-mhat; asm volatile("":"+v"(negm)); } \
    _Pragma("unroll") for(int r=0;r<16;++r){P0[r]=__builtin_amdgcn_exp2f(P0[r]); if(MASKED)P0[r]=mand(P0[r],mlo,MBIT(r));} }while(0)
  #define RESC() do{ if(resc){ asm volatile("s_waitcnt lgkmcnt(0)":::"memory"); \
      _Pragma("unroll") for(int d_=0;d_<2;++d_) _Pragma("unroll") for(int r=0;r<16;++r)o[d_][r]*=wsf[crow(r,hi)]; } }while(0)
  f32x16 pA0,pA1,pB0,pB1;
  int sl_prev=0,sl_cur=0,sl_next=SLOTB;
  #define ROT() do{sl_prev=sl_cur;sl_cur=sl_next;sl_next=(sl_next==(NSLOT-1)*SLOTB)?0:sl_next+SLOTB;}while(0)
  DMA_K(2,2*SLOTB);
  WAIT_BAR(3);
  qkt(pA0,pA1,Kbase,qr,negm,r32,hi);asm volatile("s_nop 15\n\ts_nop 7":"+v"(pA0),"+v"(pA1));CMASK(pA0,pA1,0);
  START(pA0,pA1);
  _Pragma("unroll") for(int r=0;r<16;++r){pA1[r]=__builtin_amdgcn_exp2f(pA1[r]); if(MASKED)pA1[r]=mand(pA1[r],mhi,MBIT(r));}
  WAIT_BAR(0);
  DMA_K(3,0);DMA_V(1,SLOTB);
  ROT();
  if(MASKED){mlo=nlo;mhi=nhi;}
  kload8(kf,kp0+sl_cur);
  WAIT_BAR(2);
  s16x4 vlo[8],vhi[8]; u32x4 pw0,pw1,pw2,pw3; unsigned long long nw=0ull;
  #define MROT() do{ if(MASKED){ asm volatile("":"+v"(nw)); mlo=(unsigned)nw>>(4*hi); mhi=(unsigned)(nw>>32)>>(4*hi); } }while(0)
  #define PKW(P,B) cvtpk_s(P[B],P[B+1])
  #define PAF(k) __builtin_bit_cast(bf16x8,pw##k)
  #define VFR(i) (bf16x8){vlo[i][0],vlo[i][1],vlo[i][2],vlo[i][3],vhi[i][0],vhi[i][1],vhi[i][2],vhi[i][3]}
  #define PIN(x) asm volatile("":"+v"(x))
  #define MX3(a,b,c) __builtin_fmaxf(__builtin_fmaxf((a),(b)),(c))
  #define GAPA(MF,A0,A1,A2,A3,W0,W1,PW) do{ MF; sacc+=A0; sacc+=A1; sacc+=A2; sacc+=A3; PIN(sacc); W0; W1; PIN(PW); SBAR(); }while(0)
  #define EX(v) __builtin_amdgcn_exp2f(v)
  #define GAPB(MF,X,B,W) do{ MF; X[B]=EX(X[B]); X[B+1]=EX(X[B+1]); X[B+2]=EX(X[B+2]); X[B+3]=EX(X[B+3]); if(MASKED){X[B]=mand(X[B],W,MBIT(B));X[B+1]=mand(X[B+1],W,MBIT(B+1));X[B+2]=mand(X[B+2],W,MBIT(B+2));X[B+3]=mand(X[B+3],W,MBIT(B+3));} PIN(X); SBAR(); }while(0)
  #define VRD(i) do{ vlo[i]=vtr(vp_+(((i)>>2)*4096+((i)&3)*1024)); vhi[i]=vtr(vp_+(((i)>>2)*4096+((i)&3)*1024+512)); }while(0)
  #define KRD(G,j) do{ if(G){ kload2(kf,kp0+sl_next,j); SBAR(); } }while(0)
  #define STEP(C0,C1,P0,P1,t,GK,GV,GL) do{ SBAR(); \
    if(MASKED&&(GV)){ const unsigned vo_=(unsigned)(r32<<10)+8u*(unsigned)((t)+1); asm volatile("global_load_dwordx2 %0, %1, %2":"=&v"(nw):"v"(vo_),"s"(mkw):"memory"); } \
    const lds_cptr vp_=vp0+sl_prev; \
    VRD(0); SBAR(); float sacc=(P0[0]+P0[1]); \
    GAPA(C0=__builtin_amdgcn_mfma_f32_32x32x16_bf16(kf[0],qr[0],negm,0,0,0), P0[2],P0[3],P0[4],P0[5],     pw0[0]=PKW(P0,0), pw0[1]=PKW(P0,2), pw0); \
    VRD(4); SBAR(); GAPA(C1=__builtin_amdgcn_mfma_f32_32x32x16_bf16(kf[1],qr[0],negm,0,0,0), P0[6],P0[7],P0[8],P0[9],     pw0[2]=PKW(P0,4), pw0[3]=PKW(P0,6), pw0); \
    VRD(1); SBAR(); GAPA(C0=__builtin_amdgcn_mfma_f32_32x32x16_bf16(kf[2],qr[1],C0,0,0,0),   P0[10],P0[11],P0[12],P0[13], pw1[0]=PKW(P0,8), pw1[1]=PKW(P0,10), pw1); \
    VRD(5); SBAR(); GAPA(C1=__builtin_amdgcn_mfma_f32_32x32x16_bf16(kf[3],qr[1],C1,0,0,0),   P0[14],P0[15],P1[0],P1[1],   pw1[2]=PKW(P0,12),pw1[3]=PKW(P0,14), pw1); \
    VRD(2); SBAR(); GAPA(C0=__builtin_amdgcn_mfma_f32_32x32x16_bf16(kf[4],qr[2],C0,0,0,0),   P1[2],P1[3],P1[4],P1[5],     pw2[0]=PKW(P1,0), pw2[1]=PKW(P1,2), pw2); \
    VRD(6); SBAR(); GAPA(C1=__builtin_amdgcn_mfma_f32_32x32x16_bf16(kf[5],qr[2],C1,0,0,0),   P1[6],P1[7],P1[8],P1[9],     pw2[2]=PKW(P1,4), pw2[3]=PKW(P1,6), pw2); \
    VRD(3); SBAR(); GAPA(C0=__builtin_amdgcn_mfma_f32_32x32x16_bf16(kf[6],qr[3],C0,0,0,0),   P1[10],P1[11],P1[12],P1[13], pw3[0]=PKW(P1,8), pw3[1]=PKW(P1,10), pw3); \
    VRD(7); SBAR(); GAPA(C1=__builtin_amdgcn_mfma_f32_32x32x16_bf16(kf[7],qr[3],C1,0,0,0),   P1[14],P1[15],0.f,0.f,       pw3[2]=PKW(P1,12),pw3[3]=PKW(P1,14), pw3); \
    l_reg+=sacc; \
    if(GK){DMA_K((t)+3,sl_cur);} if(GV){DMA_V((t)+1,sl_next);} \
    CMASK(C0,C1,t); \
    { float a=MX3(C0[0],C0[1],C1[0]),b=MX3(C0[2],C0[3],C1[1]); a=MX3(a,C1[2],C1[3]); \
      _Pragma("unroll") for(int r=4;r<16;r+=4){a=MX3(a,C0[r],C0[r+1]);b=MX3(b,C0[r+2],C0[r+3]);a=MX3(a,C1[r],C1[r+1]);b=MX3(b,C1[r+2],C1[r+3]);} \
      float rm=__builtin_fmaxf(a,b); { auto rr=__builtin_amdgcn_permlane32_swap(__float_as_uint(rm),__float_as_uint(rm),false,false); rm=__builtin_fmaxf(__uint_as_float(rr[0]),__uint_as_float(rr[1])); } \
      resc=false; \
      if(__builtin_expect(__any(rm>(float)THRL),0)){ const float dl=__builtin_fmaxf(rm,0.f); mhat+=dl; \
        _Pragma("unroll") for(int r=0;r<16;++r){C0[r]-=dl;C1[r]-=dl;} \
        _Pragma("unroll") for(int r=0;r<16;++r)negm[r]=-mhat; asm volatile("":"+v"(negm)); \
        const float f=__builtin_amdgcn_exp2f(-dl); l_reg*=f; if(hi==0)wsf[r32]=f; resc=true; } } \
    SBAR(); \
    GAPB(o[0]=__builtin_amdgcn_mfma_f32_32x32x16_bf16(PAF(0),VFR(0),o[0],0,0,0), C0,0,mlo); \
    GAPB(o[1]=__builtin_amdgcn_mfma_f32_32x32x16_bf16(PAF(0),VFR(4),o[1],0,0,0), C0,4,mlo); \
    KRD(GL,0); GAPB(o[0]=__builtin_amdgcn_mfma_f32_32x32x16_bf16(PAF(1),VFR(1),o[0],0,0,0), C0,8,mlo); \
    KRD(GL,1); GAPB(o[1]=__builtin_amdgcn_mfma_f32_32x32x16_bf16(PAF(1),VFR(5),o[1],0,0,0), C0,12,mlo); \
    KRD(GL,2); GAPB(o[0]=__builtin_amdgcn_mfma_f32_32x32x16_bf16(PAF(2),VFR(2),o[0],0,0,0), C1,0,mhi); \
    KRD(GL,3); GAPB(o[1]=__builtin_amdgcn_mfma_f32_32x32x16_bf16(PAF(2),VFR(6),o[1],0,0,0), C1,4,mhi); \
    GAPB(o[0]=__builtin_amdgcn_mfma_f32_32x32x16_bf16(PAF(3),VFR(3),o[0],0,0,0), C1,8,mhi); \
    GAPB(o[1]=__builtin_amdgcn_mfma_f32_32x32x16_bf16(PAF(3),VFR(7),o[1],0,0,0), C1,12,mhi); \
    }while(0)
  int t=1;
  #undef CMASK
  #define CMASK(P0,P1,t) do{}while(0)
  for(;t+5<NT;t+=2){
    STEP(pB0,pB1,pA0,pA1,t,true,true,true);     WAIT_BAR(2); MROT(); RESC(); ROT();
    STEP(pA0,pA1,pB0,pB1,t+1,true,true,true);   WAIT_BAR(2); MROT(); RESC(); ROT();
  }
  #undef CMASK
  #define CMASK(P0,P1,t) do{ if(!MASKED){ int jb_=(t)-(NT-4); if(jb_>=0)cmask(P0,P1,jb_,qrel,hi);} }while(0)
  #define ENDW(tt) do{ if((tt)+3<NT){WAIT_BAR(2);} else if((tt)+2<NT){WAIT_BAR(1);} else {WAIT_BAR(0);} }while(0)
  for(;t+1<NT;t+=2){
    STEP(pB0,pB1,pA0,pA1,t,(t+3<NT),(t+1<NT),(t+1<NT));       ENDW(t);   MROT(); RESC(); ROT();
    STEP(pA0,pA1,pB0,pB1,t+1,(t+4<NT),(t+2<NT),(t+2<NT));     ENDW(t+1); MROT(); RESC(); ROT();
  }
  STEP(pB0,pB1,pA0,pA1,NT-1,false,false,false); RESC();
  { float sacc=pB0[0]+pB0[1]; _Pragma("unroll") for(int r=2;r<16;++r)sacc+=pB0[r]; _Pragma("unroll") for(int r=0;r<16;++r)sacc+=pB1[r]; l_reg+=sacc;
    pw0=(u32x4){PKW(pB0,0),PKW(pB0,2),PKW(pB0,4),PKW(pB0,6)};pw1=(u32x4){PKW(pB0,8),PKW(pB0,10),PKW(pB0,12),PKW(pB0,14)};pw2=(u32x4){PKW(pB1,0),PKW(pB1,2),PKW(pB1,4),PKW(pB1,6)};pw3=(u32x4){PKW(pB1,8),PKW(pB1,10),PKW(pB1,12),PKW(pB1,14)};
    SBAR(); pv(o,vb0+sl_cur,PAF(0),PAF(1),PAF(2),PAF(3)); }
  #undef PKW
  #undef PAF
  #undef VFR
  #undef PIN
  #undef MX3
  #undef GAPA
  #undef GAPB
  #undef EX
  #undef VRD
  #undef KRD
  #undef STEP
  #undef ENDW
  #undef MROT
  {auto rr=__builtin_amdgcn_permlane32_swap(__float_as_uint(l_reg),__float_as_uint(l_reg),false,false);l_reg=__uint_as_float(rr[0])+__uint_as_float(rr[1]);}
  if(hi==0)wsf[32+r32]=l_reg;asm volatile("s_waitcnt lgkmcnt(0)":::"memory");
  float rli[16];
  #pragma unroll
  for(int r=0;r<16;++r)rli[r]=__builtin_amdgcn_rcpf(wsf[32+crow(r,hi)]);
  bf16*Ow=O+(rowbase+q0+wid*QBLK)*OP;
  { bf16*stg=(bf16*)(shm+LDS_OST)+wid*2048;
    #pragma unroll
    for(int r=0;r<16;++r){const int orow=crow(r,hi);
      #pragma unroll
      for(int d0=0;d0<2;++d0)stg[orow*64+d0*32+r32]=__float2bfloat16(o[d0][r]*rli[r]);}
    asm volatile("s_waitcnt lgkmcnt(0)":::"memory");
    #pragma unroll
    for(int i=0;i<4;++i){const int row=i*8+(lane>>3),ch=lane&7; const u32x4 v=*(const u32x4*)(stg+row*64+ch*8); ATTN_STORE16(Ow+(long)row*OP+ch*8,v);} }
  asm volatile("s_waitcnt lgkmcnt(0)\n\ts_barrier":::"memory");
  #undef DMA_K
  #undef DMA_V
  #undef CMASK
  #undef START
  #undef RESC
  #undef ROT
}
constexpr int ATTN_LDS_BYTES=LDS_BYTES;
#undef SBAR
#undef WAIT_BAR
}
constexpr int IX_SLOT = 8288;
constexpr int IX_HIST_OFF = 4 * IX_SLOT * 4;
constexpr int IX_CL_OFF = IX_HIST_OFF + 8 * 512 * 4;
constexpr int IX_LDS = IX_CL_OFF + 8 * 64 * 8;
DI int ix_bin(float x, float lo, float scale) { const int b = (int)((x - lo) * scale); return b > 511 ? 511 : b; }

DI void index_phase(unsigned char* ws, char* ldsc, int G, int bx, const int wid_s) {
    const int lane = lane_id_asm(), wid = wid_s, r32 = lane & 31, hi = lane >> 5;
    float* sc = (float*)ldsc;
    unsigned* hist = (unsigned*)(ldsc + IX_HIST_OFF) + wid * 512;
    uint2* clist = (uint2*)(ldsc + IX_CL_OFF) + wid * 64;
    const bf16_t* QI = (const bf16_t*)(ws + WS_QI); const bf16_t* KI = (const bf16_t*)(ws + WS_KI); const float* WI = (const float*)(ws + WS_WI);
    u64* MASK = (u64*)(ws + WS_MASK);
    for (int item = bx; item < 2048; item += G) {
        const int b = item >> 10, j = item & 1023, gA = 2047 - j, gB = j, rowbase = b * S;
        const int nA = 4 * gA + 4, nB = 4 * gB + 4, offB = (nA + 63) & ~63;
        {
            bf16x8 qa0, qa1, qb0, qb1; float wa[16], wb[16];
            { const int row = r32 & 3, head = r32 >> 2;
              const bf16_t* pa = QI + (size_t)(rowbase + 4 * gA + row) * 256 + head * 32 + 8 * hi; qa0 = *(const bf16x8*)pa; qa1 = *(const bf16x8*)(pa + 16);
              const bf16_t* pb = QI + (size_t)(rowbase + 4 * gB + row) * 256 + head * 32 + 8 * hi; qb0 = *(const bf16x8*)pb; qb1 = *(const bf16x8*)(pb + 16); }
#pragma unroll
            for (int jj = 0; jj < 4; ++jj)
#pragma unroll
                for (int row = 0; row < 4; ++row) {
                    wa[4 * jj + row] = WI[(size_t)(rowbase + 4 * gA + row) * 8 + 2 * jj + hi];
                    wb[4 * jj + row] = WI[(size_t)(rowbase + 4 * gB + row) * 8 + 2 * jj + hi];
                }
            const int ntAr = (nA + 31) >> 5, ntB = (nB + 31) >> 5;
            const f32x16 zero = {};
            for (int k = wid; k < ntAr; k += 8) {
                const bf16_t* kp = KI + (size_t)(rowbase + 32 * k + r32) * 32 + 8 * hi;
                const bf16x8 k0 = *(const bf16x8*)kp, k1 = *(const bf16x8*)(kp + 16);
                const int key = 32 * k + r32;
                {
                    f32x16 acc = MFMA32(qa0, k0, zero); acc = MFMA32(qa1, k1, acc);
                    float s[4];
#pragma unroll
                    for (int row = 0; row < 4; ++row) {
                        float t = wa[row] * fmaxf(acc[row], 0.f);
                        t += wa[4 + row] * fmaxf(acc[4 + row], 0.f); t += wa[8 + row] * fmaxf(acc[8 + row], 0.f); t += wa[12 + row] * fmaxf(acc[12 + row], 0.f);
                        s[row] = (t + __shfl_xor(t, 32)) + 0.0f;
                    }
                    sc[(2 * hi) * IX_SLOT + key] = hi ? s[2] : s[0]; sc[(2 * hi + 1) * IX_SLOT + key] = hi ? s[3] : s[1];
                }
                if (k < ntB) {
                    f32x16 acc = MFMA32(qb0, k0, zero); acc = MFMA32(qb1, k1, acc);
                    float s[4];
#pragma unroll
                    for (int row = 0; row < 4; ++row) {
                        float t = wb[row] * fmaxf(acc[row], 0.f);
                        t += wb[4 + row] * fmaxf(acc[4 + row], 0.f); t += wb[8 + row] * fmaxf(acc[8 + row], 0.f); t += wb[12 + row] * fmaxf(acc[12 + row], 0.f);
                        s[row] = (t + __shfl_xor(t, 32)) + 0.0f;
                    }
                    sc[(2 * hi) * IX_SLOT + offB + key] = hi ? s[2] : s[0]; sc[(2 * hi + 1) * IX_SLOT + offB + key] = hi ? s[3] : s[1];
                }
            }
        }
        __syncthreads();
        {
            const int slot = wid & 3, isB = wid >> 2, t = 4 * (isB ? gB : gA) + slot, n = t + 1;
            const float* base = sc + slot * IX_SLOT + (isB ? offB : 0);
            const size_t R = (size_t)rowbase + t;
            const int nw_all = 4 * (t >> 8) + 4;
            unsigned T = 0u; int kstar = 0;
            if (n > 256) {
                float lo = INFINITY, hv = -INFINITY;
                for (int i = lane * 4; i < n; i += 256) {
                    const f32x4 v = *(const f32x4*)(base + i);
#pragma unroll
                    for (int e = 0; e < 4; ++e) if (i + e < n) { lo = fminf(lo, v[e]); hv = fmaxf(hv, v[e]); }
                }
#pragma unroll
                for (int o = 1; o < 64; o <<= 1) { lo = fminf(lo, __shfl_xor(lo, o)); hv = fmaxf(hv, __shfl_xor(hv, o)); }
                const float scale = (hv > lo) ? 512.0f / (hv - lo) : 0.f;
                *(u32x4*)(hist + 8 * lane) = (u32x4){0u, 0u, 0u, 0u}; *(u32x4*)(hist + 8 * lane + 4) = (u32x4){0u, 0u, 0u, 0u};
                __builtin_amdgcn_fence(__ATOMIC_RELEASE, "workgroup");
                for (int i = lane; i < n; i += 64) __hip_atomic_fetch_add(&hist[ix_bin(base[i], lo, scale)], 1u, __ATOMIC_RELAXED, __HIP_MEMORY_SCOPE_WORKGROUP);
                __builtin_amdgcn_fence(__ATOMIC_ACQ_REL, "workgroup");
                const u32x4 h0 = *(const u32x4*)(hist + 8 * lane), h1 = *(const u32x4*)(hist + 8 * lane + 4);
                const unsigned hc[8] = {h0.x, h0.y, h0.z, h0.w, h1.x, h1.y, h1.z, h1.w};
                unsigned Ssum = (h0.x + h0.y) + (h0.z + h0.w) + (h1.x + h1.y) + (h1.z + h1.w);
#pragma unroll
                for (int o = 1; o < 64; o <<= 1) { const unsigned v = __shfl_down(Ssum, o); if (lane + o < 64) Ssum += v; }
                const u64 balS = __ballot(Ssum >= 256u);
                const int Ls = 63 - __clzll((long long)balS);
                const unsigned Snext = __shfl_down(Ssum, 1);
                unsigned cum = (lane < 63) ? Snext : 0u; int bsel = 0; unsigned abv = 0u; bool found = false;
#pragma unroll
                for (int e = 7; e >= 0; --e) { if (!found) { if (cum + hc[e] >= 256u) { bsel = 8 * lane + e; abv = cum; found = true; } else cum += hc[e]; } }
                const int bstar = __shfl(bsel, Ls); const int need = 256 - (int)__shfl(abv, Ls);
                int m = 0;
                for (int c0 = 0; c0 < n; c0 += 64) {
                    const int i = c0 + lane; const bool valid = i < n; const float x = valid ? base[i] : 0.f;
                    const bool cand = valid && ix_bin(x, lo, scale) == bstar;
                    const u64 bal = __ballot(cand);
                    if (cand) { const int pos = m + __popcll(bal & ((1ull << lane) - 1ull)); if (pos < 64) clist[pos] = make_uint2(fkey(x), (unsigned)i); }
                    m += __popcll(bal);
                }
                __builtin_amdgcn_fence(__ATOMIC_ACQ_REL, "workgroup");
                if (m <= 64) {
                    unsigned mu = 0u, mk = 0u; if (lane < m) { const uint2 e = clist[lane]; mu = e.x; mk = e.y; }
                    int rank = 0;
                    for (int jx = 0; jx < m; ++jx) { const unsigned uj = __shfl(mu, jx), kj = __shfl(mk, jx); rank += ((uj > mu) || (uj == mu && kj < mk)) ? 1 : 0; }
                    const u64 balr = __ballot(lane < m && rank == need - 1);
                    const int src = __ffsll((long long)balr) - 1;
                    T = __shfl(mu, src); kstar = (int)__shfl(mk, src);
                } else {
                    unsigned Tb = 0u;
                    for (int bit = 31; bit >= 0; --bit) {
                        const unsigned cd = Tb | (1u << bit); unsigned c = 0u;
                        for (int i = lane; i < n; i += 64) c += (fkey(base[i]) >= cd) ? 1u : 0u;
                        if (wave_sum_u(c) >= 256u) Tb = cd;
                    }
                    unsigned cg = 0u; for (int i = lane; i < n; i += 64) cg += (fkey(base[i]) > Tb) ? 1u : 0u;
                    const unsigned nd = 256u - wave_sum_u(cg);
                    int lk = 0, hk = n - 1;
                    while (lk < hk) { const int mid = (lk + hk) >> 1; unsigned c = 0u; for (int i = lane; i <= mid; i += 64) c += (fkey(base[i]) == Tb) ? 1u : 0u; if (wave_sum_u(c) >= nd) hk = mid; else lk = mid + 1; }
                    T = Tb; kstar = lk;
                }
            }
            u64 myw = 0ull;
            for (int c = 0; c < nw_all; ++c) {
                const int i = 64 * c + lane; const bool valid = i < n; const unsigned u = valid ? fkey(base[i]) : 0u;
                const bool sel = valid && (u > T || (u == T && i <= kstar));
                const u64 bal = __ballot(sel);
                if ((c & 63) == lane) myw = bal;
                if ((c & 63) == 63 || c == nw_all - 1) { const int w = (c & ~63) + lane; if (w <= c) MASK[R * 128 + w] = myw; }
            }
        }
        __syncthreads();
    }
}
#define XB_TMO      128
#define XB_XCNT(j)  (256  + 64 * (j))
#define XB_XSUB(j)  (1280 + 64 * (j))
#define XB_XGEN(j)  (2304 + 64 * (j))
#define XB_TOP      3328
#define XB_TOPGEN   3392
#define XCD_BAR_WORDS 3456
#define XB_SPIN_CAP (1u << 18)
#define LAS __attribute__((address_space(3)))

__device__ __forceinline__ unsigned xb_ld(unsigned* p)              { return __hip_atomic_load(p, __ATOMIC_RELAXED, __HIP_MEMORY_SCOPE_AGENT); }
__device__ __forceinline__ unsigned xb_add(unsigned* p, unsigned v) { return __hip_atomic_fetch_add(p, v, __ATOMIC_RELAXED, __HIP_MEMORY_SCOPE_AGENT); }
__device__ __forceinline__ unsigned xb_xcc_id() { return (unsigned)__builtin_amdgcn_s_getreg((3 << 11) | 20) & 0xFu; }
#define XB_SPIN(cond, bar) do { unsigned _sp = 0; while (cond) { __builtin_amdgcn_s_sleep(1); \
    if ((++_sp & 255u) == 0u) { if (xb_ld(&(bar)[XB_TMO])) break; if (_sp > XB_SPIN_CAP) { atomicAdd(&(bar)[XB_TMO], 1u); break; } } } } while (0)

struct XcdBarrier {
    unsigned* bar; unsigned x;
    volatile LAS unsigned* st;
};

__device__ __forceinline__ XcdBarrier xcd_barrier_post(unsigned* bar, volatile LAS unsigned* st, bool leader) {
    XcdBarrier b; b.bar = bar; b.x = xb_xcc_id(); b.st = st;
    if (leader) (void)xb_add(&bar[XB_XCNT(b.x)], 1u);
    return b;
}
__device__ __forceinline__ void xcd_barrier_complete(unsigned* bar, unsigned x, unsigned& nloc, unsigned& nx) {
    const unsigned G = gridDim.x * gridDim.y * gridDim.z;
    unsigned sum, cnt, mine, sp = 0u;
    for (;;) {
        sum = 0u; cnt = 0u; mine = 0u;
#pragma unroll
        for (unsigned j = 0; j < 16; ++j) { const unsigned c = xb_ld(&bar[XB_XCNT(j)]); sum += c; cnt += (c > 0u) ? 1u : 0u; mine = (j == x) ? c : mine; }
        if (sum == G) break;
        __builtin_amdgcn_s_sleep(1);
        if ((++sp & 255u) == 0u) { if (xb_ld(&bar[XB_TMO])) break; if (sp > XB_SPIN_CAP) { atomicAdd(&bar[XB_TMO], 1u); break; } }
    }
    nloc = mine > 0u ? mine : 1u; nx = cnt > 0u ? cnt : 1u;
}

__device__ __forceinline__ void xcd_barrier(const XcdBarrier& b, bool leader) {
    asm volatile("s_waitcnt vmcnt(0)" ::: "memory");
    __syncthreads();
    if (leader) {
        unsigned* bar = b.bar;
        __builtin_amdgcn_s_waitcnt(0);
        unsigned nloc = b.st[0], nx = b.st[1];
        if (nloc == 0u) { xcd_barrier_complete(bar, b.x, nloc, nx); b.st[0] = nloc; b.st[1] = nx; }
        const unsigned old = xb_add(&bar[XB_XSUB(b.x)], 1u);
        const unsigned gen = old / nloc;
        if (old + 1u == (gen + 1u) * nloc) {
            __builtin_amdgcn_fence(__ATOMIC_RELEASE, "agent");
            asm volatile("s_waitcnt vmcnt(0)" ::: "memory");
            const unsigned og = xb_add(&bar[XB_TOP], 1u);
            const unsigned tg = og / nx;
            if (og + 1u == (tg + 1u) * nx) xb_add(&bar[XB_TOPGEN], 1u);
            else XB_SPIN(xb_ld(&bar[XB_TOPGEN]) == tg, bar);
            __builtin_amdgcn_fence(__ATOMIC_ACQUIRE, "agent");
            xb_add(&bar[XB_XGEN(b.x)], 1u);
            asm volatile("s_waitcnt vmcnt(0)" ::: "memory");
        } else {
            XB_SPIN(xb_ld(&bar[XB_XGEN(b.x)]) == gen, bar);
            __builtin_amdgcn_fence(__ATOMIC_ACQUIRE, "agent");
            asm volatile("s_waitcnt vmcnt(0)" ::: "memory");
        }
    }
    __syncthreads();
}

using pg8::Unit;
typedef float f32x2_t __attribute__((ext_vector_type(2))); typedef __bf16 bf16x2_t __attribute__((ext_vector_type(2)));
DI unsigned cvtpk(float lo, float hi) { f32x2_t v = {lo, hi}; bf16x2_t b = __builtin_convertvector(v, bf16x2_t); return __builtin_bit_cast(unsigned, b); }
DI u32x4 pack8(const f32x4& a, const f32x4& b) { u32x4 w; w.x = cvtpk(a[0], a[1]); w.y = cvtpk(a[2], a[3]); w.z = cvtpk(b[0], b[1]); w.w = cvtpk(b[2], b[3]); return w; }
DI void unpack8(const u32x4& w, f32x4& a, f32x4& b) {
    a[0] = __uint_as_float(w.x << 16); a[1] = __uint_as_float(w.x & 0xffff0000u); a[2] = __uint_as_float(w.y << 16); a[3] = __uint_as_float(w.y & 0xffff0000u);
    b[0] = __uint_as_float(w.z << 16); b[1] = __uint_as_float(w.z & 0xffff0000u); b[2] = __uint_as_float(w.w << 16); b[3] = __uint_as_float(w.w & 0xffff0000u);
}
DI float sigmoidf_(float v) { return __builtin_amdgcn_rcpf(1.0f + __expf(-v)); }

struct EpiIn {
    static constexpr bool PERM = true, AFTER_DRAIN = false;
    unsigned char* ws; const float* ki_g; const float* ki_b; const float* gate_b;
    DI void operator()(const f32x4 (&acc)[2][2][4][2], const Unit& u, int wr, int wc, int fr, int fq) const {
        const int pn = u.pn, row0 = u.pm * 256 + wr * 64 + fr, cl0 = wc * 32 + 8 * fq;
        if (pn < 12) {
            const int seg = pn >> 1, kind = seg % 3;
            bf16_t* O = (bf16_t*)(ws + WS_QA + (size_t)seg * 16 * MiB) + (pn & 1) * 256 + cl0;
            const bool ropew = (kind != 2) && ((wc & 1) == 0);
            const float sc = (kind == 0) ? C2 : 1.0f, sg = (fq == 0) ? -1.0f : 1.0f;
            const float2* RH = (const float2*)(ws + WS_ROPE_H);
#pragma unroll
            for (int ai = 0; ai < 2; ++ai)
#pragma unroll
                for (int m = 0; m < 4; ++m) {
                    const int row = row0 + ai * 128 + m * 16;
                    f32x4 cs4[4];
                    if (ropew) { const f32x4* p = (const f32x4*)(RH + (size_t)row * 8); cs4[0] = p[0]; cs4[1] = p[1]; cs4[2] = p[2]; cs4[3] = p[3]; }
#pragma unroll
                    for (int bj = 0; bj < 2; ++bj) {
                        f32x4 v0 = acc[ai][bj][m][0], v1 = acc[ai][bj][m][1];
                        if (ropew) {
                            f32x4 p0, p1;
#pragma unroll
                            for (int i = 0; i < 4; ++i) { p0[i] = __shfl_xor(v0[i], 16); p1[i] = __shfl_xor(v1[i], 16); }
                            if (fq < 2) {
#pragma unroll
                                for (int i = 0; i < 4; ++i) {
                                    v0[i] = v0[i] * cs4[i >> 1][(i & 1) * 2] + sg * p0[i] * cs4[i >> 1][(i & 1) * 2 + 1];
                                    v1[i] = v1[i] * cs4[2 + (i >> 1)][(i & 1) * 2] + sg * p1[i] * cs4[2 + (i >> 1)][(i & 1) * 2 + 1];
                                }
                            }
                        }
                        v0 = v0 * sc; v1 = v1 * sc;
                        *(u32x4*)(O + (size_t)row * 512 + 128 * bj) = pack8(v0, v1);
                    }
                }
        } else if (pn == 12) {
            bf16_t* O = (bf16_t*)(ws + WS_QI) + cl0; const float2* RI = (const float2*)(ws + WS_ROPE_I);
#pragma unroll
            for (int ai = 0; ai < 2; ++ai)
#pragma unroll
                for (int m = 0; m < 4; ++m) {
                    const int row = row0 + ai * 128 + m * 16;
                    f32x4 ci[2];
                    if (fq == 0) { const f32x4* p = (const f32x4*)(RI + (size_t)row * 4); ci[0] = p[0]; ci[1] = p[1]; }
#pragma unroll
                    for (int bj = 0; bj < 2; ++bj) {
                        f32x4 v0 = acc[ai][bj][m][0], v1 = acc[ai][bj][m][1];
                        if (fq == 0) {
#pragma unroll
                            for (int i = 0; i < 4; ++i) { const float c = ci[i >> 1][(i & 1) * 2], s = ci[i >> 1][(i & 1) * 2 + 1], a = v0[i], b = v1[i]; v0[i] = a * c - b * s; v1[i] = b * c + a * s; }
                        }
                        *(u32x4*)(O + (size_t)row * 256 + 128 * bj) = pack8(v0, v1);
                    }
                }
        } else if (pn == 13) {
            if (wc == 0) {
                bf16_t* KI = (bf16_t*)(ws + WS_KI) + 8 * fq; const float2* RI = (const float2*)(ws + WS_ROPE_I);
                const f32x4 g0 = *(const f32x4*)(ki_g + 8 * fq), g1 = *(const f32x4*)(ki_g + 8 * fq + 4), b0 = *(const f32x4*)(ki_b + 8 * fq), b1 = *(const f32x4*)(ki_b + 8 * fq + 4);
#pragma unroll
                for (int ai = 0; ai < 2; ++ai)
#pragma unroll
                    for (int m = 0; m < 4; ++m) {
                        const int row = row0 + ai * 128 + m * 16;
                        f32x4 v0 = acc[ai][0][m][0], v1 = acc[ai][0][m][1];
                        float s = (v0[0] + v0[1]) + (v0[2] + v0[3]) + (v1[0] + v1[1]) + (v1[2] + v1[3]);
                        s += __shfl_xor(s, 16); s += __shfl_xor(s, 32);
                        const float mu = s * (1.0f / 32.0f);
                        v0 = v0 - mu; v1 = v1 - mu;
                        float q = (v0[0] * v0[0] + v0[1] * v0[1]) + (v0[2] * v0[2] + v0[3] * v0[3]) + (v1[0] * v1[0] + v1[1] * v1[1]) + (v1[2] * v1[2] + v1[3] * v1[3]);
                        q += __shfl_xor(q, 16); q += __shfl_xor(q, 32);
                        const float rs = 1.0f / sqrtf(q * (1.0f / 32.0f) + 1e-6f);
                        v0 = v0 * rs * g0 + b0; v1 = v1 * rs * g1 + b1;
                        if (fq == 0) {
                            const f32x4* p = (const f32x4*)(RI + (size_t)row * 4); const f32x4 c0 = p[0], c1 = p[1];
#pragma unroll
                            for (int i = 0; i < 4; ++i) { const float c = (i < 2 ? c0 : c1)[(i & 1) * 2], sn = (i < 2 ? c0 : c1)[(i & 1) * 2 + 1], a = v0[i], b = v1[i]; v0[i] = a * c - b * sn; v1[i] = b * c + a * sn; }
                        }
                        *(u32x4*)(KI + (size_t)row * 32) = pack8(v0, v1);
                    }
            } else if (wc == 1) {
                float* WI = (float*)(ws + WS_WI);
                if (fq == 0) {
#pragma unroll
                    for (int ai = 0; ai < 2; ++ai)
#pragma unroll
                        for (int m = 0; m < 4; ++m) {
                            const int row = row0 + ai * 128 + m * 16;
                            *(f32x4*)(WI + (size_t)row * 8) = acc[ai][0][m][0] * (1.0f / 16.0f); *(f32x4*)(WI + (size_t)row * 8 + 4) = acc[ai][0][m][1] * (1.0f / 16.0f);
                        }
                }
            }
        } else {
            const int cg0 = 256 * (pn - 14) + cl0; bf16_t* G = (bf16_t*)(ws + WS_G) + cg0;
#pragma unroll
            for (int bj = 0; bj < 2; ++bj) {
                const f32x4 gb0 = *(const f32x4*)(gate_b + cg0 + 128 * bj), gb1 = *(const f32x4*)(gate_b + cg0 + 128 * bj + 4);
#pragma unroll
                for (int ai = 0; ai < 2; ++ai)
#pragma unroll
                    for (int m = 0; m < 4; ++m) {
                        const int row = row0 + ai * 128 + m * 16;
                        f32x4 v0 = acc[ai][bj][m][0] + gb0, v1 = acc[ai][bj][m][1] + gb1;
#pragma unroll
                        for (int i = 0; i < 4; ++i) { v0[i] = sigmoidf_(v0[i]); v1[i] = sigmoidf_(v1[i]); }
                        *(u32x4*)(G + (size_t)row * 2048 + 128 * bj) = pack8(v0, v1);
                    }
            }
        }
    }
};
template <int PASS> struct EpiBranch {
    static constexpr bool PERM = true, AFTER_DRAIN = false;
    unsigned char* ws;
    DI void operator()(const f32x4 (&acc)[2][2][4][2], const Unit& u, int wr, int wc, int fr, int fq) const {
        const int row0 = u.pm * 256 + wr * 64 + fr, col0 = u.pn * 256 + wc * 32 + 8 * fq;
        const bf16_t* G = (const bf16_t*)(ws + WS_G) + (PASS - 1) * 1024 + col0; bf16_t* T = (bf16_t*)(ws + WS_T) + col0; bf16_t* MG = (bf16_t*)(ws + WS_MERGED) + col0;
#pragma unroll
        for (int ai = 0; ai < 2; ++ai)
#pragma unroll
            for (int m = 0; m < 4; ++m) {
                const int row = row0 + ai * 128 + m * 16;
#pragma unroll
                for (int bj = 0; bj < 2; ++bj) {
                    f32x4 g0, g1; unpack8(*(const u32x4*)(G + (size_t)row * 2048 + 128 * bj), g0, g1);
                    f32x4 r0 = g0 * acc[ai][bj][m][0], r1 = g1 * acc[ai][bj][m][1];
                    if (PASS == 2) { f32x4 t0, t1; unpack8(*(const u32x4*)(T + (size_t)row * 1024 + 128 * bj), t0, t1); r0 = r0 + t0; r1 = r1 + t1; }
                    *(u32x4*)((PASS == 1 ? T : MG) + (size_t)row * 1024 + 128 * bj) = pack8(r0, r1);
                }
            }
    }
};
template <bool WITH_BF> struct EpiRes {
    static constexpr bool PERM = false, AFTER_DRAIN = false;
    const float* base; float* dst; bf16_t* xb; float* RS;
    DI void operator()(const f32x4 (&acc)[2][2][4][2], const Unit& u, int wr, int wc, int fr, int fq) const {
        const int row0 = u.pm * 256 + wr * 64 + fr, col0 = u.pn * 256 + wc * 32 + 4 * fq;
#pragma unroll
        for (int ai = 0; ai < 2; ++ai)
#pragma unroll
            for (int m = 0; m < 4; ++m) {
                const int row = row0 + ai * 128 + m * 16; const size_t off = (size_t)row * 1024 + col0; float ss = 0.f;
#pragma unroll
                for (int bj = 0; bj < 2; ++bj)
#pragma unroll
                    for (int n = 0; n < 2; ++n) {
                        const f32x4 v = *(const f32x4*)(base + off + bj * 128 + n * 16) + acc[ai][bj][m][n];
                        *(f32x4*)(dst + off + bj * 128 + n * 16) = v;
                        if (WITH_BF) { uint2 w; w.x = cvtpk(v[0], v[1]); w.y = cvtpk(v[2], v[3]); *(uint2*)(xb + off + bj * 128 + n * 16) = w; }
                        ss += (v[0] * v[0] + v[1] * v[1]) + (v[2] * v[2] + v[3] * v[3]);
                    }
                ss += __shfl_xor(ss, 16); ss += __shfl_xor(ss, 32);
                if (fq == 0) RS[(size_t)row * 16 + u.pn * 4 + wc] = ss;
            }
    }
};
struct EpiFF1 {
    static constexpr bool PERM = true, AFTER_DRAIN = false;
    unsigned char* ws;
    DI void operator()(const f32x4 (&acc)[2][2][4][2], const Unit& u, int wr, int wc, int fr, int fq) const {
        const int row0 = u.pm * 256 + wr * 64 + fr, hc0 = u.pn * 128 + wc * 32 + 8 * fq;
        bf16_t* HF = (bf16_t*)(ws + WS_HF) + hc0; const float* RS = (const float*)(ws + WS_ROWSS1);
#pragma unroll
        for (int ai = 0; ai < 2; ++ai)
#pragma unroll
            for (int m = 0; m < 4; ++m) {
                const int row = row0 + ai * 128 + m * 16;
                const f32x4* rp = (const f32x4*)(RS + (size_t)row * 16); const f32x4 s4 = (rp[0] + rp[1]) + (rp[2] + rp[3]);
                const float rs = 1.0f / sqrtf(((s4[0] + s4[1]) + (s4[2] + s4[3])) * (1.0f / 1024.0f) + 1e-6f);
                f32x4 h0, h1;
#pragma unroll
                for (int i = 0; i < 4; ++i) {
                    const float g0 = acc[ai][0][m][0][i] * rs, g1 = acc[ai][0][m][1][i] * rs;
                    h0[i] = g0 * sigmoidf_(g0) * (acc[ai][1][m][0][i] * rs); h1[i] = g1 * sigmoidf_(g1) * (acc[ai][1][m][1][i] * rs);
                }
                *(u32x4*)(HF + (size_t)row * DFF) = pack8(h0, h1);
            }
    }
};

namespace cg = cooperative_groups;
constexpr int MK_THREADS = 512, MK_LDS = 159744, MK_MISC_OFF = MK_LDS - 64;
static_assert(IX_LDS <= MK_MISC_OFF && XCD_BAR_WORDS * 4 <= 16384 && attn_body::ATTN_LDS_BYTES <= MK_LDS && pg8::STAGE_BYTES <= MK_LDS, "LDS map");
struct MArgs { const float* in[19]; float* out; unsigned char* ws; int ph_lo, ph_hi; };
enum { PH_PRO = 0, PH_INPROJ = 1, PH_IXDIFF = 2, PH_DSACMB = 3, PH_BRANCH = 4, PH_OUT = 5, PH_FF1 = 6, PH_FF2 = 7, PH_FINAL = 8, PH_END = 9 };

DI void prologue_phase(const MArgs& a, char* ldsc, int vcu, int G, const int wid_s) {
    const int lane = lane_id_asm(), wid = wid_s;
    float* scr = (float*)ldsc + wid * (64 * 33);
    const int gw = vcu * 8 + wid, NGW = G * 8;
    unsigned char* ws = a.ws;
    for (int it = gw; it < IT_ALL; it += NGW) {
        int r = it;
        if (r < IT_IN) { transpose_item<1>(a.in[3], 1024, 5416, a.in[2], (bf16_t*)(ws + WS_WT_IN), r, 176, scr, lane); continue; } r -= IT_IN;
        if (r < IT_FF1) { transpose_item<2>(a.in[16], 1024, 5632, a.in[15], (bf16_t*)(ws + WS_WT_FF1), r, 176, scr, lane); continue; } r -= IT_FF1;
        if (r < IT_FF2) { transpose_item<0>(a.in[17], 2816, 1024, nullptr, (bf16_t*)(ws + WS_WT_FF2), r, 32, scr, lane); continue; } r -= IT_FF2;
        if (r < IT_OUT) { transpose_item<0>(a.in[14], 1024, 1024, nullptr, (bf16_t*)(ws + WS_WT_OUT), r, 32, scr, lane); continue; } r -= IT_OUT;
        if (r < IT_DSA) { transpose_item<0>(a.in[12], 512, 1024, nullptr, (bf16_t*)(ws + WS_WT_DSA), r, 32, scr, lane); continue; } r -= IT_DSA;
        transpose_item<0>(a.in[13], 512, 1024, nullptr, (bf16_t*)(ws + WS_WT_DIFF), r, 32, scr, lane);
    }
    const float* x = a.in[0]; const int* pos = (const int*)a.in[1];
    bf16_t* XN = (bf16_t*)(ws + WS_XN); float2* RH = (float2*)(ws + WS_ROPE_H); float2* RI = (float2*)(ws + WS_ROPE_I);
    for (int m = gw; m < M; m += NGW) {
        const f32x4* xr = (const f32x4*)(x + (size_t)m * D) + lane;
        f32x4 v[4]; float s = 0.f;
#pragma unroll
        for (int j = 0; j < 4; ++j) { v[j] = xr[64 * j]; s += (v[j].x * v[j].x + v[j].y * v[j].y) + (v[j].z * v[j].z + v[j].w * v[j].w); }
        const float rstd = 1.0f / sqrtf(wave_sum(s) * (1.f / D) + 1e-6f);
        u64* o8 = (u64*)(XN + (size_t)m * D) + lane;
#pragma unroll
        for (int j = 0; j < 4; ++j) o8[64 * j] = (u64)cvtpk(v[j].x * rstd, v[j].y * rstd) | ((u64)cvtpk(v[j].z * rstd, v[j].w * rstd) << 32);
        if (lane < 12) {
            const float p = (float)pos[m];
            const bool hd = lane < 8; const int j = hd ? lane : lane - 8;
            const float ex = hd ? -(float)(2 * j) / 16.0f : -(float)(2 * j) / 8.0f;
            const float ang = p * powf(ROPE_THETA, ex);
            float2 cs; cs.x = cosf(ang); cs.y = sinf(ang);
            if (hd) RH[(size_t)m * 8 + j] = cs; else RI[(size_t)m * 4 + j] = cs;
        }
    }
}
DI void combine_phase(const MArgs& a, int vcu, int G, const int wid_s) {
    const int lane = lane_id_asm(), gw = vcu * 8 + wid_s, NGW = G * 8;
    const bf16_t* OB1 = (const bf16_t*)((unsigned char*)a.out + DO_OB1); bf16_t* OBN = (bf16_t*)((unsigned char*)a.out + DO_OBN);
    const float s1 = wave_sum(a.in[6][lane] * a.in[7][lane]), s2 = wave_sum(a.in[8][lane] * a.in[9][lane]);
    const float lam = expf(s1) - expf(s2) + 0.2f;
    const float g0 = a.in[10][2 * lane], g1 = a.in[10][2 * lane + 1];
    for (int m = gw; m < M; m += NGW) {
#pragma unroll
        for (int h = 0; h < 4; ++h) {
            const unsigned aw = *(const unsigned*)(OB1 + (size_t)m * 1024 + (2 * h) * 128 + 2 * lane);
            const unsigned cw = *(const unsigned*)(OB1 + (size_t)m * 1024 + (2 * h + 1) * 128 + 2 * lane);
            const float v0 = __uint_as_float(aw << 16) - lam * __uint_as_float(cw << 16), v1 = __uint_as_float(aw & 0xffff0000u) - lam * __uint_as_float(cw & 0xffff0000u);
            const float ss = wave_sum(v0 * v0 + v1 * v1);
            const float rs = 0.8f / sqrtf(ss * (1.f / 128.f) + 1e-5f);
            *(unsigned*)(OBN + (size_t)m * 512 + h * 128 + 2 * lane) = cvtpk(v0 * rs * g0, v1 * rs * g1);
        }
    }
}
DI void final_phase(const MArgs& a, int vcu, int G, const int wid_s) {
    const int lane = lane_id_asm(), gw = vcu * 8 + wid_s, NGW = G * 8;
    const float* RS = (const float*)(a.ws + WS_ROWSS2); const f32x4* gv = (const f32x4*)a.in[18] + lane;
    for (int m = gw; m < M; m += NGW) {
        const f32x4* rp = (const f32x4*)(RS + (size_t)m * 16); const f32x4 s4 = (rp[0] + rp[1]) + (rp[2] + rp[3]);
        const float rs = 1.0f / sqrtf(((s4[0] + s4[1]) + (s4[2] + s4[3])) * (1.0f / 1024.0f) + 1e-6f);
        f32x4* o = (f32x4*)(a.out + (size_t)m * D) + lane;
#pragma unroll
        for (int j = 0; j < 4; ++j) { f32x4 v = o[64 * j]; v = v * rs * gv[64 * j]; o[64 * j] = v; }
    }
}

__global__ void __launch_bounds__(MK_THREADS, 2) mk_fwd(MArgs a) {
    extern __shared__ __attribute__((aligned(16))) unsigned char lds_raw[];
    PG8_LAS unsigned char* lds = (PG8_LAS unsigned char*)lds_raw;
    unsigned char* ws = a.ws; unsigned char* dob = (unsigned char*)a.out;
    const int G = gridDim.x, bx = blockIdx.x;
    const int wid_s = __builtin_amdgcn_readfirstlane(threadIdx.x >> 6);
    const int vcu = (G % 8 == 0) ? (bx % 8) * (G / 8) + bx / 8 : bx;
#define IN(k) (a.ph_lo <= (k) && (k) < a.ph_hi)
#define SEAM(k) do { if (IN(k) && IN((k) + 1)) xcd_barrier(xbar, leader); } while (0)
    volatile LAS unsigned* misc = (volatile LAS unsigned*)(lds + MK_MISC_OFF);
    if (threadIdx.x < 2) misc[threadIdx.x] = 0u;
    cg::this_grid().sync();
    const bool leader = (wid_s == 0) && (lane_id_asm() == 0);
    const XcdBarrier xbar = xcd_barrier_post((unsigned*)(ws + WS_CTL), misc, leader);
    if (IN(PH_PRO)) prologue_phase(a, (char*)lds_raw, vcu, G, wid_s);
    SEAM(PH_PRO);
    if (IN(PH_INPROJ)) {
        pg8::Gemm g{(const bf16_t*)(ws + WS_XN), (const bf16_t*)(ws + WS_WT_IN), M, NPROJ, 1024}; pg8::StaticOrder So; So.init(M, NPROJ, G, bx);
        EpiIn E{ws, a.in[4], a.in[5], a.in[11]};
        pg8::gemm_phase<EpiIn, pg8::StaticOrder, true, true>(lds, g, So, E, wid_s);
    }
    SEAM(PH_INPROJ);
    if (IN(PH_IXDIFF)) {
        index_phase(ws, (char*)lds_raw, G, bx, wid_s);
        typedef attn_body::bf16 abf;
        for (int L = vcu; L < 256; L += G) {
            for (int i = 0; i < 4; ++i) {
                int Lo = L; asm volatile("" : "+s"(Lo));
                const int bh = Lo >> 3, s = Lo & 7, b = bh >> 4, p = bh & 15, hm = p >> 1, vh = p & 1, h = hm >> 1;
                const int qb = (i == 0) ? s : (i == 1) ? 15 - s : (i == 2) ? 16 + s : 31 - s;
                attn_body::attn_unit<8, 512, 512, 512, 1024, false>(b, qb, (const abf*)(ws + WS_QB) + hm * 64, (const abf*)(ws + WS_KB) + hm * 64, (const abf*)(ws + WS_VB) + h * 128 + vh * 64,
                                                                (abf*)(dob + DO_OB1) + hm * 128 + vh * 64, nullptr, (char*)lds_raw, wid_s);
            }
        }
    }
    SEAM(PH_IXDIFF);
    if (IN(PH_DSACMB)) {
        typedef attn_body::bf16 abf;
        for (int L = vcu; L < 256; L += G) {
            for (int i = 0; i < 2; ++i) {
                int Lo = L; asm volatile("" : "+s"(Lo));
                const int bh = Lo >> 4, s = Lo & 15, b = bh >> 3, h = bh & 7;
                const int qb = (i == 0) ? s : 31 - s;
                attn_body::attn_unit<8, 512, 512, 512, 512, true>(b, qb, (const abf*)(ws + WS_QA) + h * 64, (const abf*)(ws + WS_KA) + h * 64, (const abf*)(ws + WS_VA) + h * 64,
                                                              (abf*)(ws + WS_QA) + h * 64, (const u64*)(ws + WS_MASK), (char*)lds_raw, wid_s);
            }
        }
        combine_phase(a, vcu, G, wid_s);
    }
    SEAM(PH_DSACMB);
    if (IN(PH_BRANCH)) {
        { pg8::Gemm g{(const bf16_t*)(ws + WS_QA), (const bf16_t*)(ws + WS_WT_DSA), M, 1024, 512}; pg8::StaticOrder So; So.init(M, 1024, G, bx);
          EpiBranch<1> E{ws}; pg8::gemm_phase<EpiBranch<1>, pg8::StaticOrder, true, true>(lds, g, So, E, wid_s); }
        { pg8::Gemm g{(const bf16_t*)(dob + DO_OBN), (const bf16_t*)(ws + WS_WT_DIFF), M, 1024, 512}; pg8::StaticOrder So; So.init(M, 1024, G, bx);
          EpiBranch<2> E{ws}; pg8::gemm_phase<EpiBranch<2>, pg8::StaticOrder, true, true>(lds, g, So, E, wid_s); }
    }
    SEAM(PH_BRANCH);
    if (IN(PH_OUT)) {
        pg8::Gemm g{(const bf16_t*)(ws + WS_MERGED), (const bf16_t*)(ws + WS_WT_OUT), M, 1024, 1024}; pg8::StaticOrder So; So.init(M, 1024, G, bx);
        EpiRes<true> E{a.in[0], a.out, (bf16_t*)(ws + WS_X1B), (float*)(ws + WS_ROWSS1)};
        pg8::gemm_phase<EpiRes<true>, pg8::StaticOrder, true, true>(lds, g, So, E, wid_s);
    }
    SEAM(PH_OUT);
    if (IN(PH_FF1)) {
        pg8::Gemm g{(const bf16_t*)(ws + WS_X1B), (const bf16_t*)(ws + WS_WT_FF1), M, NFF1, 1024}; pg8::StaticOrder So; So.init(M, NFF1, G, bx);
        EpiFF1 E{ws}; pg8::gemm_phase<EpiFF1, pg8::StaticOrder, true, true>(lds, g, So, E, wid_s);
    }
    SEAM(PH_FF1);
    if (IN(PH_FF2)) {
        pg8::Gemm g{(const bf16_t*)(ws + WS_HF), (const bf16_t*)(ws + WS_WT_FF2), M, 1024, DFF}; pg8::StaticOrder So; So.init(M, 1024, G, bx);
        EpiRes<false> E{a.out, a.out, nullptr, (float*)(ws + WS_ROWSS2)};
        pg8::gemm_phase<EpiRes<false>, pg8::StaticOrder, true, true>(lds, g, So, E, wid_s);
    }
    SEAM(PH_FF2);
    if (IN(PH_FINAL)) final_phase(a, vcu, G, wid_s);
#undef IN
#undef SEAM
}

extern "C" void kernel_launch(void* const* d_in, const int* in_sizes, int n_in, void* d_out, int out_size, void* d_ws, size_t ws_size, hipStream_t stream) {
    if (n_in != 19 || out_size != M * D || ws_size < WS_END) { fprintf(stderr, "kernel_launch: unexpected shapes (n_in %d out %d ws %zu)\n", n_in, out_size, ws_size); return; }
    static int grid = 0;
    if (!grid) {
        if (hipFuncSetAttribute((const void*)mk_fwd, hipFuncAttributeMaxDynamicSharedMemorySize, MK_LDS) != hipSuccess) fprintf(stderr, "kernel_launch: hipFuncSetAttribute failed\n");
        int dev = 0, cus = 0, per_cu = 0;
        hipGetDevice(&dev); hipDeviceGetAttribute(&cus, hipDeviceAttributeMultiprocessorCount, dev);
        if (hipOccupancyMaxActiveBlocksPerMultiprocessor(&per_cu, (const void*)mk_fwd, MK_THREADS, MK_LDS) != hipSuccess || per_cu < 1) { fprintf(stderr, "kernel_launch: occupancy query gave %d\n", per_cu); per_cu = 1; }
        grid = cus * per_cu;
        (void)hipGetLastError();
    }
    if (hipMemsetAsync((char*)d_ws + WS_CTL, 0, 16384, stream) != hipSuccess) { fprintf(stderr, "kernel_launch: memset of the barrier words failed\n"); return; }
    MArgs ma{};
    for (int i = 0; i < 19; ++i) ma.in[i] = (const float*)d_in[i];
    ma.out = (float*)d_out; ma.ws = (unsigned char*)d_ws; ma.ph_lo = 0; ma.ph_hi = PH_END;
    void* args[] = {&ma};
    const hipError_t e = hipLaunchCooperativeKernel((const void*)mk_fwd, dim3(grid), dim3(MK_THREADS), args, MK_LDS, stream);
    if (e != hipSuccess) fprintf(stderr, "kernel_launch: cooperative launch failed: %s (grid %d)\n", hipGetErrorString(e), grid);
}
```

```cpp
#include <hip/hip_runtime.h>
#include <hip/hip_cooperative_groups.h>
#include <cstdint>
#include <cstdio>

#define DI __device__ __forceinline__
typedef unsigned short bf16_t;
typedef short bf16x8 __attribute__((ext_vector_type(8)));
typedef float f32x16 __attribute__((ext_vector_type(16)));
typedef float f32x4 __attribute__((ext_vector_type(4)));
typedef unsigned u32x4 __attribute__((ext_vector_type(4)));
typedef unsigned long long u64;

constexpr int NB = 2, S = 8192, D = 1024, M = NB * S;
constexpr int NPROJ = 5632, DFF = 2816, NFF1 = 5632;
constexpr float C2 = 0.125f * 1.4426950408889634f;
constexpr float ROPE_THETA = 500000.0f;

constexpr size_t MiB = 1u << 20;
constexpr size_t WS_CTL = 0;
constexpr size_t WS_WT_IN = 1 * MiB, WS_WT_FF1 = 12 * MiB, WS_WT_FF2 = 23 * MiB, WS_WT_OUT = 29 * MiB, WS_WT_DSA = 31 * MiB, WS_WT_DIFF = 32 * MiB;
constexpr size_t WS_ROPE_H = 33 * MiB, WS_ROPE_I = 34 * MiB, WS_ROWSS1 = 34 * MiB + 512 * 1024;
constexpr size_t WS_XN = 36 * MiB, WS_MASK = 36 * MiB, WS_T = 36 * MiB;
constexpr size_t WS_QA = 68 * MiB, WS_KA = 84 * MiB, WS_VA = 100 * MiB, WS_QB = 116 * MiB, WS_KB = 132 * MiB, WS_VB = 148 * MiB;
constexpr size_t WS_QI = 164 * MiB, WS_KI = 172 * MiB, WS_WI = 173 * MiB;
constexpr size_t WS_G = 174 * MiB, WS_ROWSS2 = 238 * MiB;
constexpr size_t WS_MERGED = 84 * MiB, WS_X1B = 116 * MiB, WS_HF = 148 * MiB;
constexpr size_t WS_END = 256 * MiB;
constexpr size_t DO_OB1 = 0, DO_OBN = 32 * MiB, DO_OA = 48 * MiB;
constexpr size_t WS_X2 = 36 * MiB;

DI int lane_id_asm() { int l; asm volatile("v_mbcnt_lo_u32_b32 %0, -1, 0\n\tv_mbcnt_hi_u32_b32 %0, -1, %0" : "=v"(l)); return l; }
DI float bf2f(bf16_t v) { return __uint_as_float((unsigned)v << 16); }
DI bf16_t f2bf(float f) { unsigned u = __float_as_uint(f); return (bf16_t)((u + 0x7fffu + ((u >> 16) & 1u)) >> 16); }
DI unsigned pk2(float lo, float hi) { return (unsigned)f2bf(lo) | ((unsigned)f2bf(hi) << 16); }
DI int crow(int r, int hi) { return (r & 3) + 8 * (r >> 2) + 4 * hi; }
DI float wave_sum(float v) {
#pragma unroll
    for (int o = 1; o < 64; o <<= 1) v += __shfl_xor(v, o);
    return v;
}
DI float wave_max(float v) {
#pragma unroll
    for (int o = 1; o < 64; o <<= 1) v = fmaxf(v, __shfl_xor(v, o));
    return v;
}
DI unsigned wave_sum_u(unsigned v) {
#pragma unroll
    for (int o = 1; o < 64; o <<= 1) v += __shfl_xor(v, o);
    return v;
}

DI int map_in(int v) {
    if (v < 1536) return v;
    if (v < 3072) return 1832 + (v - 1536);
    if (v < 3328) return 1536 + (v - 3072);
    if (v < 3360) return 1792 + (v - 3328);
    if (v < 3368) return 1824 + (v - 3360);
    if (v < 3584) return -1;
    return 3368 + (v - 3584);
}
DI int map_ff1(int v) { const int pn = v >> 8, o = v & 255; return (o < 128) ? (128 * pn + o) : (DFF + 128 * pn + (o - 128)); }

template <int MAPK> DI void transpose_item(const float* W, int K, int Nsrc, const float* gain, bf16_t* WT, int item, int nblk, float* scr, int lane) {
    const int kb = item / nblk, nb = item % nblk, k0 = 64 * kb, n0 = 32 * nb;
    const int v = n0 + (lane & 31);
    const int src = MAPK == 1 ? map_in(v) : (MAPK == 2 ? map_ff1(v) : v);
#pragma unroll 8
    for (int i = 0; i < 32; ++i) {
        const int kk = 2 * i + (lane >> 5);
        float x = (src >= 0) ? W[(size_t)(k0 + kk) * Nsrc + src] : 0.f;
        if (gain) x *= gain[k0 + kk];
        scr[kk * 33 + (lane & 31)] = x;
    }
    asm volatile("s_waitcnt lgkmcnt(0)" ::: "memory");
    const int c = lane & 7;
#pragma unroll
    for (int j = 0; j < 4; ++j) {
        const int n = (lane >> 3) + 8 * j; const float* s = scr + (8 * c) * 33 + n;
        u32x4 o; o.x = pk2(s[0 * 33], s[1 * 33]); o.y = pk2(s[2 * 33], s[3 * 33]); o.z = pk2(s[4 * 33], s[5 * 33]); o.w = pk2(s[6 * 33], s[7 * 33]);
        *(u32x4*)(WT + (size_t)(n0 + n) * K + k0 + 8 * c) = o;
    }
    asm volatile("s_waitcnt lgkmcnt(0)" ::: "memory");
}

struct PArgs {
    const float* in[19]; float* out; unsigned char* ws;
};

constexpr int IT_IN = 16 * 176, IT_FF1 = 16 * 176, IT_FF2 = 44 * 32, IT_OUT = 16 * 32, IT_DSA = 8 * 32, IT_DIFF = 8 * 32;
constexpr int IT_ALL = IT_IN + IT_FF1 + IT_FF2 + IT_OUT + IT_DSA + IT_DIFF;

__global__ void __launch_bounds__(64) nk_prologue(PArgs a) {
    __shared__ float scr[64 * 33];
    const int lane = threadIdx.x;
    const int gw = blockIdx.x, NGW = gridDim.x;
    unsigned char* ws = a.ws;
    for (int it = gw; it < IT_ALL; it += NGW) {
        int r = it;
        if (r < IT_IN) { transpose_item<1>(a.in[3], 1024, 5416, a.in[2], (bf16_t*)(ws + WS_WT_IN), r, 176, scr, lane); continue; } r -= IT_IN;
        if (r < IT_FF1) { transpose_item<2>(a.in[16], 1024, 5632, a.in[15], (bf16_t*)(ws + WS_WT_FF1), r, 176, scr, lane); continue; } r -= IT_FF1;
        if (r < IT_FF2) { transpose_item<0>(a.in[17], 2816, 1024, nullptr, (bf16_t*)(ws + WS_WT_FF2), r, 32, scr, lane); continue; } r -= IT_FF2;
        if (r < IT_OUT) { transpose_item<0>(a.in[14], 1024, 1024, nullptr, (bf16_t*)(ws + WS_WT_OUT), r, 32, scr, lane); continue; } r -= IT_OUT;
        if (r < IT_DSA) { transpose_item<0>(a.in[12], 512, 1024, nullptr, (bf16_t*)(ws + WS_WT_DSA), r, 32, scr, lane); continue; } r -= IT_DSA;
        transpose_item<0>(a.in[13], 512, 1024, nullptr, (bf16_t*)(ws + WS_WT_DIFF), r, 32, scr, lane);
    }
    const float* x = a.in[0]; const int* pos = (const int*)a.in[1];
    bf16_t* XN = (bf16_t*)(ws + WS_XN); float2* RH = (float2*)(ws + WS_ROPE_H); float2* RI = (float2*)(ws + WS_ROPE_I);
    for (int m = gw; m < M; m += NGW) {
        const f32x4* xr = (const f32x4*)(x + (size_t)m * D) + lane;
        f32x4 v[4]; float s = 0.f;
#pragma unroll
        for (int j = 0; j < 4; ++j) { v[j] = xr[64 * j]; s += (v[j].x * v[j].x + v[j].y * v[j].y) + (v[j].z * v[j].z + v[j].w * v[j].w); }
        const float rstd = 1.0f / sqrtf(wave_sum(s) * (1.f / D) + 1e-6f);
        u64* o8 = (u64*)(XN + (size_t)m * D) + lane;
#pragma unroll
        for (int j = 0; j < 4; ++j) o8[64 * j] = (u64)pk2(v[j].x * rstd, v[j].y * rstd) | ((u64)pk2(v[j].z * rstd, v[j].w * rstd) << 32);
        if (lane < 12) {
            const float p = (float)pos[m];
            const bool hd = lane < 8; const int j = hd ? lane : lane - 8;
            const float ex = hd ? -(float)(2 * j) / 16.0f : -(float)(2 * j) / 8.0f;
            const float inv = powf(ROPE_THETA, ex);
            const float ang = p * inv;
            float2 cs; cs.x = cosf(ang); cs.y = sinf(ang);
            if (hd) RH[(size_t)m * 8 + j] = cs; else RI[(size_t)m * 4 + j] = cs;
        }
    }
}

#define MFMA32(a, b, c) __builtin_amdgcn_mfma_f32_32x32x16_bf16((a), (b), (c), 0, 0, 0)
template <class Epi, bool DUAL>
__global__ void __launch_bounds__(256) ngemm_k(const bf16_t* A, int lda, const bf16_t* Bt, int ldb, int K, int ntn, Epi epi) {
    __shared__ float Cs[128][65];
    __shared__ float Cs2[DUAL ? 128 : 1][65];
    const int tile = blockIdx.x, tn = tile % ntn, tm = tile / ntn;
    const int tid = threadIdx.x, wid = tid >> 6, lane = tid & 63, r = lane & 31, h = lane >> 5;
    const int n0 = DUAL ? ((tn >> 1) * 256 + (tn & 1) * 64) : tn * 64;
    const int m0 = tm * 128 + wid * 32;
    f32x16 acc0 = {}, acc1 = {}, acc2 = {}, acc3 = {};
    const bf16_t* ap = A + (size_t)(m0 + r) * lda + 8 * h;
    const bf16_t* bp0 = Bt + (size_t)(n0 + r) * ldb + 8 * h;
    const bf16_t* bp1 = bp0 + (size_t)32 * ldb;
    const bf16_t* bp2 = bp0 + (size_t)128 * ldb;
    const bf16_t* bp3 = bp0 + (size_t)160 * ldb;
    for (int k = 0; k < K; k += 16) {
        const bf16x8 av = *(const bf16x8*)(ap + k), b0 = *(const bf16x8*)(bp0 + k), b1 = *(const bf16x8*)(bp1 + k);
        acc0 = MFMA32(av, b0, acc0); acc1 = MFMA32(av, b1, acc1);
        if (DUAL) { const bf16x8 b2 = *(const bf16x8*)(bp2 + k), b3 = *(const bf16x8*)(bp3 + k); acc2 = MFMA32(av, b2, acc2); acc3 = MFMA32(av, b3, acc3); }
    }
#pragma unroll
    for (int i = 0; i < 16; ++i) {
        const int rr = wid * 32 + crow(i, h);
        Cs[rr][r] = acc0[i]; Cs[rr][32 + r] = acc1[i];
        if (DUAL) { Cs2[rr][r] = acc2[i]; Cs2[rr][32 + r] = acc3[i]; }
    }
    __syncthreads();
    epi(tm * 128, n0, Cs, Cs2, tid);
}

struct NEpiIn {
    unsigned char* ws; const float* ki_g; const float* ki_b; const float* gate_b;
    DI void operator()(int m0, int n0, float (*Cs)[65], float (*)[65], int tid) const {
        const float2* RH = (const float2*)(ws + WS_ROPE_H); const float2* RI = (const float2*)(ws + WS_ROPE_I);
        if (n0 < 3072) {
            const int seg = n0 / 512, cb = n0 % 512;
            bf16_t* O = (bf16_t*)(ws + WS_QA + (size_t)seg * 16 * MiB);
            const bool rope = (seg % 3) != 2, isq = (seg % 3) == 0;
            for (int e = tid; e < 128 * 64; e += 256) {
                const int row = e >> 6, c = e & 63; float v = Cs[row][c];
                if (rope && c < 16) { const float2 cs = RH[(size_t)(m0 + row) * 8 + (c & 7)];
                    v = (c < 8) ? (v * cs.x - Cs[row][c + 8] * cs.y) : (v * cs.x + Cs[row][c - 8] * cs.y); }
                if (isq) v *= C2;
                O[(size_t)(m0 + row) * 512 + cb + c] = f2bf(v);
            }
        } else if (n0 < 3328) {
            bf16_t* O = (bf16_t*)(ws + WS_QI);
            for (int e = tid; e < 128 * 64; e += 256) {
                const int row = e >> 6, c = e & 63, c32 = c & 31; float v = Cs[row][c];
                if (c32 < 8) { const float2 cs = RI[(size_t)(m0 + row) * 4 + (c32 & 3)];
                    v = (c32 < 4) ? (v * cs.x - Cs[row][c + 4] * cs.y) : (v * cs.x + Cs[row][c - 4] * cs.y); }
                O[(size_t)(m0 + row) * 256 + (n0 - 3072) + c] = f2bf(v);
            }
        } else if (n0 == 3328) {
            bf16_t* KI = (bf16_t*)(ws + WS_KI); float* WI = (float*)(ws + WS_WI);
            for (int e = tid; e < 128 * 40; e += 256) {
                const int row = e / 40, c = e % 40;
                if (c < 32) {
                    float mu = 0.f; for (int j = 0; j < 32; ++j) mu += Cs[row][j]; mu *= (1.f / 32.f);
                    float var = 0.f; for (int j = 0; j < 32; ++j) { const float d = Cs[row][j] - mu; var += d * d; } var *= (1.f / 32.f);
                    const float rs = 1.0f / sqrtf(var + 1e-6f);
                    float v = (Cs[row][c] - mu) * rs * ki_g[c] + ki_b[c];
                    if (c < 8) { const int cp = (c < 4) ? c + 4 : c - 4; const float vp = (Cs[row][cp] - mu) * rs * ki_g[cp] + ki_b[cp];
                        const float2 cs = RI[(size_t)(m0 + row) * 4 + (c & 3)];
                        v = (c < 4) ? (v * cs.x - vp * cs.y) : (v * cs.x + vp * cs.y); }
                    KI[(size_t)(m0 + row) * 32 + c] = f2bf(v);
                } else WI[(size_t)(m0 + row) * 8 + (c - 32)] = Cs[row][c] * (1.0f / 16.0f);
            }
        } else if (n0 >= 3584) {
            bf16_t* G = (bf16_t*)(ws + WS_G);
            for (int e = tid; e < 128 * 64; e += 256) {
                const int row = e >> 6, c = e & 63, cg = n0 - 3584 + c;
                const float v = Cs[row][c] + gate_b[cg];
                G[(size_t)(m0 + row) * 2048 + cg] = f2bf(1.0f / (1.0f + __expf(-v)));
            }
        }
    }
};
template <int PASS> struct NEpiBranch {
    unsigned char* ws;
    DI void operator()(int m0, int n0, float (*Cs)[65], float (*)[65], int tid) const {
        const bf16_t* G = (const bf16_t*)(ws + WS_G); bf16_t* T = (bf16_t*)(ws + WS_T); bf16_t* MG = (bf16_t*)(ws + WS_MERGED);
        for (int e = tid; e < 128 * 64; e += 256) {
            const int row = e >> 6, c = e & 63; const size_t o = (size_t)(m0 + row) * 1024 + n0 + c;
            const float g = bf2f(G[(size_t)(m0 + row) * 2048 + (PASS - 1) * 1024 + n0 + c]);
            if (PASS == 1) T[o] = f2bf(g * Cs[row][c]); else MG[o] = f2bf(bf2f(T[o]) + g * Cs[row][c]);
        }
    }
};
struct NEpiOut {
    unsigned char* ws; const float* x; float* out;
    DI void operator()(int m0, int n0, float (*Cs)[65], float (*)[65], int tid) const {
        bf16_t* X1B = (bf16_t*)(ws + WS_X1B); float* RS = (float*)(ws + WS_ROWSS1);
        for (int e = tid; e < 128 * 64; e += 256) {
            const int row = e >> 6, c = e & 63; const size_t o = (size_t)(m0 + row) * 1024 + n0 + c;
            const float v = x[o] + Cs[row][c]; out[o] = v; X1B[o] = f2bf(v); Cs[row][c] = v;
        }
        __syncthreads();
        if (tid < 128) { float s = 0.f; for (int c = 0; c < 64; ++c) s += Cs[tid][c] * Cs[tid][c]; RS[(size_t)(m0 + tid) * 16 + (n0 >> 6)] = s; }
    }
};
DI float row_rstd(const float* RS, int row) { float s = 0.f; for (int i = 0; i < 16; ++i) s += RS[(size_t)row * 16 + i]; return 1.0f / sqrtf(s * (1.f / 1024.f) + 1e-6f); }
struct NEpiFF1 {
    unsigned char* ws;
    DI void operator()(int m0, int n0, float (*Cs)[65], float (*Cs2)[65], int tid) const {
        bf16_t* HF = (bf16_t*)(ws + WS_HF); const float* RS = (const float*)(ws + WS_ROWSS1);
        const int hc = (n0 >> 8) * 128 + (n0 & 255);
        for (int e = tid; e < 128 * 64; e += 256) {
            const int row = e >> 6, c = e & 63; const float rs = row_rstd(RS, m0 + row);
            const float g = Cs[row][c] * rs, u = Cs2[row][c] * rs;
            HF[(size_t)(m0 + row) * DFF + hc + c] = f2bf(g / (1.0f + __expf(-g)) * u);
        }
    }
};
struct NEpiFF2 {
    unsigned char* ws; float* out;
    DI void operator()(int m0, int n0, float (*Cs)[65], float (*)[65], int tid) const {
        float* RS = (float*)(ws + WS_ROWSS2);
        for (int e = tid; e < 128 * 64; e += 256) {
            const int row = e >> 6, c = e & 63; const size_t o = (size_t)(m0 + row) * 1024 + n0 + c;
            const float v = out[o] + Cs[row][c]; out[o] = v; Cs[row][c] = v;
        }
        __syncthreads();
        if (tid < 128) { float s = 0.f; for (int c = 0; c < 64; ++c) s += Cs[tid][c] * Cs[tid][c]; RS[(size_t)(m0 + tid) * 16 + (n0 >> 6)] = s; }
    }
};
__global__ void __launch_bounds__(256) nk_final(float* out, const float* RS, const float* g) {
    const int lane = threadIdx.x & 63, gw = blockIdx.x * 4 + (threadIdx.x >> 6), NGW = gridDim.x * 4;
    for (int m = gw; m < M; m += NGW) {
        const float rs = row_rstd(RS, m);
        f32x4* o = (f32x4*)(out + (size_t)m * D) + lane; const f32x4* gv = (const f32x4*)g + lane;
#pragma unroll
        for (int j = 0; j < 4; ++j) { f32x4 v = o[64 * j]; const f32x4 gg = gv[64 * j]; v = v * rs * gg; o[64 * j] = v; }
    }
}

DI unsigned fkey(float f) { const unsigned u = __float_as_uint(f); return (u & 0x80000000u) ? ~u : (u | 0x80000000u); }
__global__ void __launch_bounds__(256) nk_index(const bf16_t* QI, const bf16_t* KI, const float* WI, u64* MASK) {
    __shared__ unsigned su[8192];
    __shared__ unsigned short slist[8192];
    __shared__ float sq[256]; __shared__ float sw[8];
    __shared__ unsigned scnt, scnt2;
    const int tid = threadIdx.x, lane = tid & 63, wid = tid >> 6;
    for (int row = blockIdx.x; row < M; row += gridDim.x) {
        const int b = row / S, t = row % S, n = t + 1;
        sq[tid] = bf2f(QI[(size_t)row * 256 + tid]); if (tid < 8) sw[tid] = WI[(size_t)row * 8 + tid];
        __syncthreads();
        if (n <= 256) {
            if (tid < 128) { const int lo = 64 * tid; MASK[(size_t)row * 128 + tid] = (n - lo >= 64) ? ~0ull : (n > lo ? ((1ull << (n - lo)) - 1ull) : 0ull); }
            __syncthreads();
            continue;
        }
        for (int key = tid; key < n; key += 256) {
            const bf16x8* kp = (const bf16x8*)(KI + ((size_t)b * S + key) * 32);
            float kf[32];
#pragma unroll
            for (int c = 0; c < 4; ++c) { const bf16x8 v = kp[c];
#pragma unroll
                for (int j = 0; j < 8; ++j) kf[c * 8 + j] = bf2f((bf16_t)v[j]); }
            float sc = 0.f;
#pragma unroll
            for (int h = 0; h < 8; ++h) { float d = 0.f;
#pragma unroll
                for (int j = 0; j < 32; ++j) d += sq[h * 32 + j] * kf[j];
                sc += sw[h] * fmaxf(d, 0.f); }
            su[key] = fkey(sc);
        }
        __syncthreads();
        unsigned T = 0;
        for (int bit = 31; bit >= 0; --bit) {
            const unsigned cand = T | (1u << bit);
            if (tid == 0) scnt = 0;
            __syncthreads();
            unsigned c = 0; for (int key = tid; key < n; key += 256) c += (su[key] >= cand) ? 1u : 0u;
            c = wave_sum_u(c); if (lane == 0) atomicAdd(&scnt, c);
            __syncthreads();
            if (scnt >= 256u) T = cand;
            __syncthreads();
        }
        if (tid == 0) { scnt = 0; scnt2 = 0; }
        __syncthreads();
        { unsigned c = 0;
          for (int key = tid; key < n; key += 256) { const unsigned u = su[key]; if (u > T) ++c; else if (u == T) { const unsigned p = atomicAdd(&scnt2, 1u); slist[p] = (unsigned short)key; } }
          c = wave_sum_u(c); if (lane == 0) atomicAdd(&scnt, c); }
        __syncthreads();
        const int need = 256 - (int)scnt, mt = (int)scnt2;
        for (int i = tid; i < mt; i += 256) { const int idx = slist[i]; int rank = 0; for (int j = 0; j < mt; ++j) rank += (slist[j] < idx) ? 1 : 0; if (rank < need) su[idx] = 0xFFFFFFFFu; }
        __syncthreads();
        for (int c = wid; c < 128; c += 4) { const int key = 64 * c + lane; const bool sel = key < n && su[key] > T; const u64 bal = __ballot(sel); if (lane == 0) MASK[(size_t)row * 128 + c] = bal; }
        __syncthreads();
    }
}

__global__ void __launch_bounds__(64) nk_dsa(bf16_t* QAO, const bf16_t* KA, const bf16_t* VA, const u64* MASK) {
    __shared__ unsigned short slist[576]; __shared__ float sp[576]; __shared__ float sqh[64];
    const int lane = threadIdx.x;
    for (int row = blockIdx.x; row < M; row += gridDim.x) {
        const int b = row / S;
        u64 w0 = MASK[(size_t)row * 128 + lane], w1 = MASK[(size_t)row * 128 + 64 + lane];
        const int c0 = __popcll(w0), c1 = __popcll(w1);
        int i0 = c0, i1 = c1;
#pragma unroll
        for (int o = 1; o < 64; o <<= 1) { const int a0 = __shfl_up(i0, o), a1 = __shfl_up(i1, o); if (lane >= o) { i0 += a0; i1 += a1; } }
        const int tot0 = __shfl(i0, 63), tot1 = __shfl(i1, 63);
        int off0 = i0 - c0, off1 = tot0 + i1 - c1;
        int cnt = tot0 + tot1; if (cnt > 512) cnt = 512;
        while (w0) { const int bit = __ffsll((long long)w0) - 1; if (off0 < 512) slist[off0] = (unsigned short)(64 * lane + bit); ++off0; w0 &= w0 - 1; }
        while (w1) { const int bit = __ffsll((long long)w1) - 1; if (off1 < 512) slist[off1] = (unsigned short)(64 * (64 + lane) + bit); ++off1; w1 &= w1 - 1; }
        __syncthreads();
        for (int h = 0; h < 8; ++h) {
            sqh[lane] = bf2f(QAO[(size_t)row * 512 + h * 64 + lane]);
            __syncthreads();
            float mx = -INFINITY;
            for (int i = lane; i < cnt; i += 64) {
                const int key = slist[i]; const bf16x8* kp = (const bf16x8*)(KA + ((size_t)b * S + key) * 512 + h * 64);
                float s = 0.f;
#pragma unroll
                for (int c = 0; c < 8; ++c) { const bf16x8 v = kp[c];
#pragma unroll
                    for (int j = 0; j < 8; ++j) s += sqh[c * 8 + j] * bf2f((bf16_t)v[j]); }
                sp[i] = s; mx = fmaxf(mx, s);
            }
            mx = wave_max(mx);
            float l = 0.f;
            for (int i = lane; i < cnt; i += 64) { const float p = exp2f(sp[i] - mx); sp[i] = p; l += p; }
            l = wave_sum(l);
            __syncthreads();
            float o = 0.f;
            for (int i = 0; i < cnt; ++i) { const int key = slist[i]; o += sp[i] * bf2f(VA[((size_t)b * S + key) * 512 + h * 64 + lane]); }
            o /= l;
            __syncthreads();
            QAO[(size_t)row * 512 + h * 64 + lane] = f2bf(o);
        }
        __syncthreads();
    }
}

__global__ void __launch_bounds__(256) nk_diff(const bf16_t* QB, const bf16_t* KB, const bf16_t* VB, bf16_t* OB1) {
    __shared__ float Ks[32][64]; __shared__ float Vs[32][128];
    const int blk = blockIdx.x, qb = 63 - (blk & 63), hm = (blk >> 6) & 7, b = blk >> 9, h = hm >> 1;
    const int tid = threadIdx.x, qr = tid & 127, vh = tid >> 7;
    const int t = qb * 128 + qr; const size_t row = (size_t)b * S + t;
    float q[64], o[64];
    { const bf16x8* qp = (const bf16x8*)(QB + row * 512 + hm * 64);
#pragma unroll
      for (int c = 0; c < 8; ++c) { const bf16x8 v = qp[c];
#pragma unroll
          for (int j = 0; j < 8; ++j) q[c * 8 + j] = bf2f((bf16_t)v[j]); } }
#pragma unroll
    for (int d = 0; d < 64; ++d) o[d] = 0.f;
    float m = -INFINITY, l = 0.f;
    const int ntile = (qb * 128 + 128) / 32;
    for (int kt = 0; kt < ntile; ++kt) {
        __syncthreads();
        { const size_t kr = (size_t)b * S + kt * 32 + (tid >> 3);
          const bf16x8 v = *(const bf16x8*)(KB + kr * 512 + hm * 64 + (tid & 7) * 8);
#pragma unroll
          for (int j = 0; j < 8; ++j) Ks[tid >> 3][(tid & 7) * 8 + j] = bf2f((bf16_t)v[j]);
          const bf16x8* vp = (const bf16x8*)(VB + kr * 512 + h * 128 + (tid & 7) * 16);
          const bf16x8 v0 = vp[0], v1 = vp[1];
#pragma unroll
          for (int j = 0; j < 8; ++j) { Vs[tid >> 3][(tid & 7) * 16 + j] = bf2f((bf16_t)v0[j]); Vs[tid >> 3][(tid & 7) * 16 + 8 + j] = bf2f((bf16_t)v1[j]); } }
        __syncthreads();
        float s[32]; float tm = -INFINITY;
#pragma unroll
        for (int j = 0; j < 32; ++j) {
            float a = 0.f;
#pragma unroll
            for (int d = 0; d < 64; ++d) a += q[d] * Ks[j][d];
            if (kt * 32 + j > t) a = -INFINITY;
            s[j] = a; tm = fmaxf(tm, a);
        }
        const float mn = fmaxf(m, tm);
        const float sc = exp2f(m - mn);
        l *= sc;
#pragma unroll
        for (int d = 0; d < 64; ++d) o[d] *= sc;
        m = mn;
#pragma unroll
        for (int j = 0; j < 32; ++j) {
            const float p = exp2f(s[j] - m); l += p;
#pragma unroll
            for (int d = 0; d < 64; ++d) o[d] += p * Vs[j][vh * 64 + d];
        }
    }
    const float inv = 1.0f / l;
    bf16_t* op = OB1 + row * 1024 + hm * 128 + vh * 64;
#pragma unroll
    for (int d = 0; d < 64; ++d) op[d] = f2bf(o[d] * inv);
}
__global__ void __launch_bounds__(256) nk_diff_combine(const bf16_t* OB1, bf16_t* OBN, const float* lq1, const float* lk1, const float* lq2, const float* lk2, const float* g) {
    const int lane = threadIdx.x & 63, gw = blockIdx.x * 4 + (threadIdx.x >> 6), NGW = gridDim.x * 4;
    const float s1 = wave_sum(lq1[lane] * lk1[lane]), s2 = wave_sum(lq2[lane] * lk2[lane]);
    const float lam = expf(s1) - expf(s2) + 0.2f;
    const float g0 = g[2 * lane], g1 = g[2 * lane + 1];
    for (int m = gw; m < M; m += NGW) {
#pragma unroll
        for (int h = 0; h < 4; ++h) {
            const unsigned a = *(const unsigned*)(OB1 + (size_t)m * 1024 + (2 * h) * 128 + 2 * lane);
            const unsigned c = *(const unsigned*)(OB1 + (size_t)m * 1024 + (2 * h + 1) * 128 + 2 * lane);
            const float v0 = bf2f((bf16_t)(a & 0xffff)) - lam * bf2f((bf16_t)(c & 0xffff)), v1 = bf2f((bf16_t)(a >> 16)) - lam * bf2f((bf16_t)(c >> 16));
            const float ss = wave_sum(v0 * v0 + v1 * v1);
            const float rs = 0.8f / sqrtf(ss * (1.f / 128.f) + 1e-5f);
            *(unsigned*)(OBN + (size_t)m * 512 + h * 128 + 2 * lane) = pk2(v0 * rs * g0, v1 * rs * g1);
        }
    }
}

namespace pg8 {
#define PG8_LAS __attribute__((address_space(3)))
typedef unsigned short bf16_t;
typedef short bf16x8 __attribute__((ext_vector_type(8)));
typedef float f32x4 __attribute__((ext_vector_type(4)));
typedef unsigned u32x4 __attribute__((ext_vector_type(4)));
constexpr int BM = 256, BK = 64, HALF = 128, HTB = HALF * BK * 2  , STAGE_BYTES = 8 * HTB, NXCD = 8, WGM = 8;

__host__ __device__ __forceinline__ int lds_byte(int r, int c) { const int st = (r >> 4) * 2 + (c >> 5), rr = r & 15, cc = c & 31, ob = rr * 64 + cc * 2; return st * 1024 + (ob ^ (((ob >> 9) & 1) << 5)); }
__host__ __device__ __forceinline__ void stage_rc(int b, int& R, int& C) { const int st = b / 1024, sb = b % 1024, swz = sb ^ (((sb >> 9) & 1) << 5); R = (st >> 1) * 16 + swz / 64; C = (st & 1) * 32 + (swz % 64) / 2; }
__host__ __device__ __forceinline__ int perm32(int rho) { const int n = rho >> 4, i = rho & 15; return 8 * (i >> 2) + 4 * n + (i & 3); }

struct Unit { int pm, pn; };
struct Gemm { const bf16_t* A; const bf16_t* Bt; int M, N, K; };

struct StaticOrder {
    int nM, nN, nwg, G, c;
    __host__ __device__ void init(int M, int N, int G_, int c_) { nM = M / BM; nN = N / BM; nwg = nM * nN; G = G_; c = c_; }
    __host__ __device__ bool next(int i, Unit& u) const {
        const long L = (long)i * G + c; if (L >= nwg) return false;
        int wgid = (int)L; { const int q = nwg / NXCD, r = nwg % NXCD, xcd = wgid % NXCD, off = wgid / NXCD; wgid = (xcd < r ? xcd * (q + 1) : r * (q + 1) + (xcd - r) * q) + off; }
        const int nig = WGM * nN, gid = wgid / nig, fm = gid * WGM, gsz = (nM - fm) < WGM ? (nM - fm) : WGM;
        u.pm = fm + ((wgid % nig) % gsz); u.pn = (wgid % nig) / gsz; return true;
    }
    __device__ __forceinline__ void a_ready(const Unit&) const {}
    __device__ __forceinline__ void done(const Unit&) const {}
};

__device__ __forceinline__ unsigned cvt_pk_bf16(float lo, float hi) { unsigned r; asm volatile("v_cvt_pk_bf16_f32 %0, %1, %2" : "=v"(r) : "v"(lo), "v"(hi)); return r; }
template <class Epi, class Sched, bool ALIGN_EPI = false, bool SP2 = false>
__device__ __forceinline__ void gemm_phase(PG8_LAS unsigned char* lds, const Gemm g, const Sched& S, const Epi& E, const int wid_s) {
    const int tid = wid_s * 64 + lane_id_asm(), wid = wid_s, lane = tid & 63, wr = wid >> 2, wc = wid & 3, fr = lane & 15, fq = lane >> 4;
    const int K = g.K, nt = K / BK;
    unsigned voffA[2], voffB[2];
#pragma unroll
    for (int i = 0; i < 2; ++i) { int R, C; stage_rc(tid * 16 + i * 8192, R, C); const int Rb = Epi::PERM ? ((R & ~31) + perm32(R & 31)) : R;
        voffA[i] = (unsigned)(R * K + C) * 2u; voffB[i] = (unsigned)(Rb * K + C) * 2u; }
    const size_t kstep = (size_t)(BK * 2);
    const size_t hstep = (size_t)HALF * K * 2;
    const size_t tstep = 2 * hstep;
    const unsigned ldsw = (unsigned)wid * 1024u;
    const int aoff = lds_byte(wr * 64 + fr, fq * 8), boff = lds_byte(wc * 32 + fr, fq * 8);
#define PG8_SA(b, h) (((b) * 2 + (h)) * HTB)
#define PG8_SB(b, h) ((4 + (b) * 2 + (h)) * HTB)
#define PG8_STAGE(bufoff, gbase, voff) do { _Pragma("unroll") for (int _i = 0; _i < 2; ++_i) \
        __builtin_amdgcn_global_load_lds((const unsigned*)((const char*)(gbase) + (voff)[_i]), (PG8_LAS unsigned*)(lds + (bufoff) + ldsw + _i * 8192), 16, 0, 0); } while (0)
#define PG8_LDA(dst, b, h) do { _Pragma("unroll") for (int m = 0; m < 4; ++m) _Pragma("unroll") for (int k = 0; k < 2; ++k) dst[m][k] = *(const PG8_LAS bf16x8*)(lds + PG8_SA(b, h) + aoff + m * 2048 + k * 1024); } while (0)
#define PG8_LDB(dst, b, h) do { _Pragma("unroll") for (int n = 0; n < 2; ++n) _Pragma("unroll") for (int k = 0; k < 2; ++k) dst[n][k] = *(const PG8_LAS bf16x8*)(lds + PG8_SB(b, h) + boff + n * 2048 + k * 1024); } while (0)
#define PG8_MMA(ai, bj, At, Bt) do { __builtin_amdgcn_s_setprio(1); _Pragma("unroll") for (int m = 0; m < 4; ++m) _Pragma("unroll") for (int n = 0; n < 2; ++n) _Pragma("unroll") for (int k = 0; k < 2; ++k) \
        acc[ai][bj][m][n] = __builtin_amdgcn_mfma_f32_16x16x32_bf16(Bt[n][k], At[m][k], acc[ai][bj][m][n], 0, 0, 0); __builtin_amdgcn_s_setprio(0); } while (0)
#define PG8_WAIT_V(n) asm volatile("s_waitcnt vmcnt(" #n ")" ::: "memory")
#define PG8_WAIT_L(n) asm volatile("s_waitcnt lgkmcnt(" #n ")" ::: "memory")
#define PG8_BAR __builtin_amdgcn_s_barrier()
#define PG8_SCHED __builtin_amdgcn_sched_barrier(0)
    Unit cur, nxt; int ui = 0;
    if (!S.next(0, cur)) return;
    f32x4 acc[2][2][4][2];
#pragma unroll
    for (int a = 0; a < 2; ++a)
#pragma unroll
        for (int b = 0; b < 2; ++b)
#pragma unroll
            for (int m = 0; m < 4; ++m)
#pragma unroll
                for (int n = 0; n < 2; ++n) acc[a][b][m][n] = (f32x4){0.f, 0.f, 0.f, 0.f};
    bf16x8 At[4][2], B0[2][2], B1[2][2];
    const char* cA = (const char*)g.A + (size_t)cur.pm * tstep; const char* cB = (const char*)g.Bt + (size_t)cur.pn * tstep;
    S.a_ready(cur);
    if constexpr (SP2) {
        PG8_STAGE(PG8_SB(0, 0), cB, voffB); PG8_STAGE(PG8_SB(0, 1), cB + hstep, voffB); PG8_STAGE(PG8_SA(0, 0), cA, voffA); PG8_STAGE(PG8_SA(0, 1), cA + hstep, voffA);
        if (wr == 1) PG8_BAR;
        PG8_WAIT_V(2); PG8_BAR;
        PG8_STAGE(PG8_SB(1, 0), cB + kstep, voffB); PG8_STAGE(PG8_SA(1, 0), cA + kstep, voffA); PG8_STAGE(PG8_SB(1, 1), cB + hstep + kstep, voffB);
        PG8_WAIT_V(6); PG8_BAR;
    } else {
        PG8_STAGE(PG8_SB(0, 0), cB, voffB); PG8_STAGE(PG8_SA(0, 0), cA, voffA); PG8_STAGE(PG8_SB(0, 1), cB + hstep, voffB); PG8_STAGE(PG8_SA(0, 1), cA + hstep, voffA);
        if (wr == 1) PG8_BAR;
        PG8_WAIT_V(4); PG8_BAR;
        PG8_STAGE(PG8_SB(1, 0), cB + kstep, voffB); PG8_STAGE(PG8_SA(1, 0), cA + kstep, voffA); PG8_STAGE(PG8_SB(1, 1), cB + hstep + kstep, voffB);
        PG8_WAIT_V(6); PG8_BAR;
    }
    for (;;) {
        const bool has_next = S.next(ui + 1, nxt);
        const char* nA = has_next ? (const char*)g.A + (size_t)nxt.pm * tstep : cA; const char* nB = has_next ? (const char*)g.Bt + (size_t)nxt.pn * tstep : cB;
        for (int t = 0; t < nt; t += 2) {
            const bool last = (t == nt - 2);
            const char* a1 = cA + (size_t)(t + 1) * kstep;
            const char* a2 = last ? nA : cA + (size_t)(t + 2) * kstep; const char* b2 = last ? nB : cB + (size_t)(t + 2) * kstep;
            const char* a3 = a2 + kstep; const char* b3 = b2 + kstep;
            if (last && has_next) S.a_ready(nxt);
            if constexpr (SP2) {
            PG8_LDB(B0, 0, 0); PG8_LDB(B1, 0, 1); PG8_SCHED; PG8_LDA(At, 0, 0); PG8_STAGE(PG8_SA(1, 1), a1 + hstep, voffA);
            PG8_WAIT_V(8); PG8_WAIT_L(0); PG8_BAR; PG8_MMA(0, 0, At, B0); PG8_MMA(0, 1, At, B1); PG8_BAR; PG8_SCHED;
            PG8_LDA(At, 0, 1); PG8_STAGE(PG8_SB(0, 0), b2, voffB); PG8_STAGE(PG8_SB(0, 1), b2 + hstep, voffB); PG8_STAGE(PG8_SA(0, 0), a2, voffA);
            PG8_WAIT_V(8); PG8_WAIT_L(0); PG8_BAR; PG8_MMA(1, 0, At, B0); PG8_MMA(1, 1, At, B1); PG8_BAR; PG8_SCHED;
            PG8_LDB(B0, 1, 0); PG8_LDB(B1, 1, 1); PG8_SCHED; PG8_LDA(At, 1, 0); PG8_STAGE(PG8_SA(0, 1), a2 + hstep, voffA);
            PG8_WAIT_V(8); PG8_WAIT_L(0); PG8_BAR; PG8_MMA(0, 0, At, B0); PG8_MMA(0, 1, At, B1); PG8_BAR; PG8_SCHED;
            PG8_LDA(At, 1, 1); PG8_STAGE(PG8_SB(1, 0), b3, voffB); PG8_STAGE(PG8_SB(1, 1), b3 + hstep, voffB); PG8_STAGE(PG8_SA(1, 0), a3, voffA);
            PG8_WAIT_V(8); PG8_WAIT_L(0); PG8_BAR; PG8_MMA(1, 0, At, B0); PG8_MMA(1, 1, At, B1); PG8_BAR; PG8_SCHED;
            } else {
            PG8_LDB(B0, 0, 0); PG8_SCHED; PG8_LDA(At, 0, 0); PG8_STAGE(PG8_SA(1, 1), a1 + hstep, voffA);
            PG8_WAIT_L(8); PG8_BAR; PG8_WAIT_L(0); PG8_MMA(0, 0, At, B0); PG8_BAR; PG8_SCHED;
            PG8_LDB(B1, 0, 1); PG8_STAGE(PG8_SB(0, 0), b2, voffB);
            PG8_BAR; PG8_WAIT_L(0); PG8_MMA(0, 1, At, B1); PG8_BAR;
            PG8_LDA(At, 0, 1); PG8_STAGE(PG8_SA(0, 0), a2, voffA);
            PG8_BAR; PG8_WAIT_L(0); PG8_MMA(1, 0, At, B0); PG8_BAR; PG8_SCHED;
            PG8_STAGE(PG8_SB(0, 1), b2 + hstep, voffB);
            PG8_WAIT_V(6); PG8_BAR; PG8_MMA(1, 1, At, B1); PG8_BAR;
            PG8_LDB(B0, 1, 0); PG8_SCHED; PG8_LDA(At, 1, 0); PG8_STAGE(PG8_SA(0, 1), a2 + hstep, voffA);
            PG8_WAIT_L(8); PG8_BAR; PG8_WAIT_L(0); PG8_MMA(0, 0, At, B0); PG8_BAR; PG8_SCHED;
            PG8_LDB(B1, 1, 1); PG8_STAGE(PG8_SB(1, 0), b3, voffB);
            PG8_BAR; PG8_WAIT_L(0); PG8_MMA(0, 1, At, B1); PG8_BAR;
            PG8_LDA(At, 1, 1); PG8_STAGE(PG8_SA(1, 0), a3, voffA);
            PG8_BAR; PG8_WAIT_L(0); PG8_MMA(1, 0, At, B0); PG8_BAR; PG8_SCHED;
            PG8_STAGE(PG8_SB(1, 1), b3 + hstep, voffB);
            PG8_WAIT_V(6); PG8_BAR; PG8_MMA(1, 1, At, B1); PG8_BAR;
            }
        }
        if constexpr (ALIGN_EPI) { if (wr == 0) PG8_BAR; }
        if constexpr (!Epi::AFTER_DRAIN) { E(acc, cur, wr, wc, fr, fq); S.done(cur); __builtin_amdgcn_s_waitcnt(0x0F70);   }
        if (!has_next) break;
#pragma unroll
        for (int a = 0; a < 2; ++a)
#pragma unroll
            for (int b = 0; b < 2; ++b)
#pragma unroll
                for (int m = 0; m < 4; ++m)
#pragma unroll
                    for (int n = 0; n < 2; ++n) acc[a][b][m][n] = (f32x4){0.f, 0.f, 0.f, 0.f};
        cur = nxt; cA = nA; cB = nB; ++ui;
        if constexpr (ALIGN_EPI) { if (wr == 1) PG8_BAR; }
    }
    PG8_WAIT_V(0);
    if constexpr (!ALIGN_EPI) { if (wr == 0) PG8_BAR; }
    PG8_BAR;
    if constexpr (Epi::AFTER_DRAIN) { E.fused(acc, cur, wr, wc, fr, fq, lds, wid, lane); S.done(cur); }
#undef PG8_SA
#undef PG8_SB
#undef PG8_STAGE
#undef PG8_LDA
#undef PG8_LDB
#undef PG8_MMA
#undef PG8_WAIT_V
#undef PG8_WAIT_L
#undef PG8_BAR
#undef PG8_SCHED
}
}
#include <hip/hip_bf16.h>
#include <cmath>
namespace attn_body {
using bf16=__hip_bfloat16;
using bf16x8=__attribute__((ext_vector_type(8)))short;
using s16x4=__attribute__((ext_vector_type(4)))short;
using f32x16=__attribute__((ext_vector_type(16)))float;
using u32x4=__attribute__((ext_vector_type(4)))unsigned;
constexpr int BATCH=2,NHEAD=16,SEQ=8192,D=64,DM=NHEAD*D;
constexpr int NW=8,QBLK=32,QB=QBLK*NW,KVBLK=64,NQB=SEQ/QB;
constexpr int ATTN_PITCH=DM, ATTN_UNIT_ROWS=QB;
__device__ __forceinline__ int crow(int r,int hi){return (r&3)+8*(r>>2)+4*hi;}
#define SBAR() __builtin_amdgcn_sched_barrier(0)
__device__ __forceinline__ void cmask(f32x16&p0,f32x16&p1,int jb,int qrel,int hi){
  const float NEG=-INFINITY; int kb=64*jb+4*hi;
  #pragma unroll
  for(int r=0;r<16;++r){int kv=kb+(r&3)+8*(r>>2); if(kv>qrel)p0[r]=NEG; if(kv+32>qrel)p1[r]=NEG;}
}

constexpr int NSLOT=3, SLOTB=8192;
constexpr int LDS_K=0, LDS_V=NSLOT*SLOTB, LDS_WS=2*NSLOT*SLOTB, LDS_OST=LDS_WS+NW*64*4, LDS_BYTES=LDS_OST+NW*4096;
constexpr float C2=0.125f*1.4426950408889634f;
__device__ __forceinline__ void glds16(const void*gsrc,unsigned lds_dst){unsigned keep;
  asm volatile("s_mov_b32 %0, m0\n\ts_mov_b32 m0, %2\n\ts_nop 0\n\tglobal_load_lds_dwordx4 %1, off\n\ts_mov_b32 m0, %0":"=&s"(keep):"v"(gsrc),"s"(lds_dst):"memory");}
__device__ __forceinline__ float max3f(float a,float b,float c){float r;asm("v_max3_f32 %0, %1, %2, %3":"=v"(r):"v"(a),"v"(b),"v"(c));return r;}
__device__ __forceinline__ float max2f(float a,float b){float r;asm("v_max_f32_e32 %0, %1, %2":"=v"(r):"v"(a),"v"(b));return r;}
__device__ __forceinline__ float fadd_s(float a,float b){float r;asm("v_add_f32_e32 %0, %1, %2":"=v"(r):"v"(a),"v"(b));return r;}
__device__ __forceinline__ float fsub_s(float a,float b){float r;asm("v_sub_f32_e32 %0, %1, %2":"=v"(r):"v"(a),"v"(b));return r;}
typedef float f32x2_t __attribute__((ext_vector_type(2))); typedef __bf16 bf16x2_t __attribute__((ext_vector_type(2)));
__device__ __forceinline__ unsigned cvtpk_s(float lo,float hi){f32x2_t v={lo,hi};bf16x2_t b=__builtin_convertvector(v,bf16x2_t);return __builtin_bit_cast(unsigned,b);}
#define WAIT_BAR(N) asm volatile("s_waitcnt vmcnt(" #N ") lgkmcnt(0)\n\ts_barrier":::"memory")

__device__ __forceinline__ void qkt(f32x16&p0,f32x16&p1,const char*Kslot,const bf16x8*qr,const f32x16&negm,int r32,int hi){
  const char*kb=Kslot+hi*1024+r32*16;
  #pragma unroll
  for(int d0=0;d0<4;++d0){
    const bf16x8 b0=*reinterpret_cast<const bf16x8*>(kb+d0*2048);
    const bf16x8 b1=*reinterpret_cast<const bf16x8*>(kb+d0*2048+512);
    if(d0==0){p0=__builtin_amdgcn_mfma_f32_32x32x16_bf16(b0,qr[0],negm,0,0,0);p1=__builtin_amdgcn_mfma_f32_32x32x16_bf16(b1,qr[0],negm,0,0,0);}
    else{p0=__builtin_amdgcn_mfma_f32_32x32x16_bf16(b0,qr[d0],p0,0,0,0);p1=__builtin_amdgcn_mfma_f32_32x32x16_bf16(b1,qr[d0],p1,0,0,0);}}
}
typedef __attribute__((address_space(3))) const char* lds_cptr;
typedef short v4i16_t __attribute__((ext_vector_type(4)));
__device__ __forceinline__ void kload8(bf16x8*kf,lds_cptr kp){
  kf[0]=*(const __attribute__((address_space(3))) bf16x8*)(kp);      kf[1]=*(const __attribute__((address_space(3))) bf16x8*)(kp+512);
  kf[2]=*(const __attribute__((address_space(3))) bf16x8*)(kp+2048); kf[3]=*(const __attribute__((address_space(3))) bf16x8*)(kp+2560);
  kf[4]=*(const __attribute__((address_space(3))) bf16x8*)(kp+4096); kf[5]=*(const __attribute__((address_space(3))) bf16x8*)(kp+4608);
  kf[6]=*(const __attribute__((address_space(3))) bf16x8*)(kp+6144); kf[7]=*(const __attribute__((address_space(3))) bf16x8*)(kp+6656);
}
__device__ __forceinline__ void kload2(bf16x8*kf,lds_cptr kp,int j){ kf[2*j]=*(const __attribute__((address_space(3))) bf16x8*)(kp+j*2048); kf[2*j+1]=*(const __attribute__((address_space(3))) bf16x8*)(kp+j*2048+512); }
__device__ __forceinline__ s16x4 vtr(lds_cptr p){ return __builtin_bit_cast(s16x4,__builtin_amdgcn_ds_read_tr16_b64_v4i16((__attribute__((address_space(3))) v4i16_t*)p)); }
__device__ __forceinline__ float rowmax(const f32x16&p0,const f32x16&p1){
  float a=max3f(p0[0],p0[1],p1[0]),b=max3f(p0[2],p0[3],p1[1]);a=max3f(a,p1[2],p1[3]);
  #pragma unroll
  for(int r=4;r<16;r+=4){a=max3f(a,p0[r],p0[r+1]);b=max3f(b,p0[r+2],p0[r+3]);a=max3f(a,p1[r],p1[r+1]);b=max3f(b,p1[r+2],p1[r+3]);}
  const float m=max2f(a,b);
  auto rr=__builtin_amdgcn_permlane32_swap(__float_as_uint(m),__float_as_uint(m),false,false);
  return max2f(__uint_as_float(rr[0]),__uint_as_float(rr[1]));
}
__device__ __forceinline__ void pv(f32x16*o,int vb,bf16x8 pa0,bf16x8 pa1,bf16x8 pa2,bf16x8 pa3){
  #pragma unroll
  for(int d0=0;d0<2;++d0){s16x4 lo[4],hi[4];
    #pragma unroll
    for(int ks=0;ks<4;++ks){
      asm volatile("ds_read_b64_tr_b16 %0,%1 offset:%c2":"=&v"(lo[ks]):"v"(vb),"i"(d0*4096+ks*1024):"memory");
      asm volatile("ds_read_b64_tr_b16 %0,%1 offset:%c2":"=&v"(hi[ks]):"v"(vb),"i"(d0*4096+ks*1024+512):"memory");}
    asm volatile("s_waitcnt lgkmcnt(0)":::"memory");SBAR();
    #define PK(k) (bf16x8){lo[k][0],lo[k][1],lo[k][2],lo[k][3],hi[k][0],hi[k][1],hi[k][2],hi[k][3]}
    o[d0]=__builtin_amdgcn_mfma_f32_32x32x16_bf16(pa0,PK(0),o[d0],0,0,0);
    o[d0]=__builtin_amdgcn_mfma_f32_32x32x16_bf16(pa1,PK(1),o[d0],0,0,0);
    o[d0]=__builtin_amdgcn_mfma_f32_32x32x16_bf16(pa2,PK(2),o[d0],0,0,0);
    o[d0]=__builtin_amdgcn_mfma_f32_32x32x16_bf16(pa3,PK(3),o[d0],0,0,0);
    #undef PK
  }
}

__device__ __forceinline__ float mand(float x,unsigned w,int c){ const int m=((int)(w<<(31-c)))>>31; return __int_as_float(__float_as_int(x)&m); }
#define MBIT(r) (((r)&3)+8*((r)>>2))
#ifndef ATTN_STORE16
#define ATTN_STORE16(p,v) (*(u32x4*)(p)=(v))
#endif
template<int THRL,int QP,int KP,int VP,int OP,bool MASKED> __device__ __forceinline__ void attn_unit(int b,int qb,const bf16*Q,const bf16*__restrict__ K,const bf16*__restrict__ V,bf16*O,const unsigned long long*MK,char*shm,const int wid_s){
  const int lane=lane_id_asm(),tid=wid_s*64+lane,r32=lane&31,hi=lane>>5; const int wid=wid_s; (void)tid;
  const long rowbase=(long)b*SEQ; const int q0=qb*QB;
  const bf16*Qw=Q+(rowbase+q0+wid*QBLK)*QP;
  const bf16*Kh=K+rowbase*KP,*Vh=V+rowbase*VP;
  const unsigned lds0=(unsigned)(uintptr_t)shm;
  float*wsf=(float*)(shm+LDS_WS)+wid*64;
  const bf16*ksrc=Kh+(long)lane*KP+wid*8;
  const bf16*vsrc=Vh+(long)(16*(wid&3)+(lane>>2))*VP+(wid>>2)*32+(lane&3)*8;
  const unsigned kdst=lds0+LDS_K+wid*1024, vdst=lds0+LDS_V+wid*1024;
  #define DMA_K(t,slot) glds16(ksrc+(long)(t)*KVBLK*KP,(unsigned)__builtin_amdgcn_readfirstlane(kdst+(slot)))
  #define DMA_V(t,slot) glds16(vsrc+(long)(t)*KVBLK*VP,(unsigned)__builtin_amdgcn_readfirstlane(vdst+(slot)))
  const int vb0=(int)(lds0+LDS_V)+((lane>>4)&1)*32+(lane&3)*8+(4*hi+((lane&15)>>2))*64;
  const char*Kbase=shm+LDS_K; bf16x8 kf[8];
  const lds_cptr shm3=(lds_cptr)shm; const lds_cptr kp0=shm3+LDS_K+hi*1024+r32*16; const lds_cptr vp0=shm3+LDS_V+((lane>>4)&1)*32+(lane&3)*8+(4*hi+((lane&15)>>2))*64;
  const int NT=(q0+QB)/KVBLK;
  DMA_K(0,0);DMA_V(0,0);DMA_K(1,SLOTB);
  const unsigned long long*mkw=MK+((rowbase+q0+wid*QBLK)<<7);
  const unsigned long long*mkp=mkw+(r32<<7);
  unsigned mlo=0u,mhi=0u,nlo=0u,nhi=0u;
  if(MASKED){ const unsigned long long w0=mkp[0],w1=mkp[1]; mlo=(unsigned)w0>>(4*hi); mhi=(unsigned)(w0>>32)>>(4*hi); nlo=(unsigned)w1>>(4*hi); nhi=(unsigned)(w1>>32)>>(4*hi); }
  bf16x8 qr[4];
  #pragma unroll
  for(int d0=0;d0<4;++d0)qr[d0]=*reinterpret_cast<const bf16x8*>(&Qw[(long)r32*QP+d0*16+hi*8]);
  float zf_; asm volatile("v_mov_b32 %0, 0":"=v"(zf_));
  float mhat=zf_,l_reg=zf_;f32x16 o[2];
  _Pragma("unroll") for(int r=0;r<16;++r){o[0][r]=zf_;o[1][r]=zf_;}
  f32x16 negm; _Pragma("unroll") for(int r=0;r<16;++r)negm[r]=zf_; asm volatile("":"+v"(negm));
  const int qrel=wid*QBLK+r32;
  #define CMASK(P0,P1,t) do{ if(!MASKED){ int jb_=(t)-(NT-4); if(jb_>=0)cmask(P0,P1,jb_,qrel,hi);} }while(0)
  bool resc=false;
  #define START(P0,P1) do{ const float rm=rowmax(P0,P1); resc=false; \
    { const float dl=rm; mhat=fadd_s(mhat,dl); \
      _Pragma("unroll") for(int r=0;r<16;++r){P0[r]=fsub_s(P0[r],dl);P1[r]=fsub_s(P1[r],dl);} \
      _Pragma("unroll") for(int r=0;r<16;++r)negm[r]=-mhat; asm volatile("":"+v"(negm)); } \
    _Pragma("unroll") for(int r=0;r<16;++r){P0[r]=__builtin_amdgcn_exp2f(P0[r]); if(MASKED)P0[r]=mand(P0[r],mlo,MBIT(r));} }while(0)
  #define RESC() do{ if(resc){ asm volatile("s_waitcnt lgkmcnt(0)":::"memory"); \
      _Pragma("unroll") for(int d_=0;d_<2;++d_) _Pragma("unroll") for(int r=0;r<16;++r)o[d_][r]*=wsf[crow(r,hi)]; } }while(0)
  f32x16 pA0,pA1,pB0,pB1;
  int sl_prev=0,sl_cur=0,sl_next=SLOTB;
  #define ROT() do{sl_prev=sl_cur;sl_cur=sl_next;sl_next=(sl_next==(NSLOT-1)*SLOTB)?0:sl_next+SLOTB;}while(0)
  DMA_K(2,2*SLOTB);
  WAIT_BAR(3);
  qkt(pA0,pA1,Kbase,qr,negm,r32,hi);asm volatile("s_nop 15\n\ts_nop 7":"+v"(pA0),"+v"(pA1));CMASK(pA0,pA1,0);
  START(pA0,pA1);
  _Pragma("unroll") for(int r=0;r<16;++r){pA1[r]=__builtin_amdgcn_exp2f(pA1[r]); if(MASKED)pA1[r]=mand(pA1[r],mhi,MBIT(r));}
  WAIT_BAR(0);
  DMA_K(3,0);DMA_V(1,SLOTB);
  ROT();
  if(MASKED){mlo=nlo;mhi=nhi;}
  kload8(kf,kp0+sl_cur);
  WAIT_BAR(2);
  s16x4 vlo[8],vhi[8]; u32x4 pw0,pw1,pw2,pw3; unsigned long long nw=0ull;
  #define MROT() do{ if(MASKED){ asm volatile("":"+v"(nw)); mlo=(unsigned)nw>>(4*hi); mhi=(unsigned)(nw>>32)>>(4*hi); } }while(0)
  #define PKW(P,B) cvtpk_s(P[B],P[B+1])
  #define PAF(k) __builtin_bit_cast(bf16x8,pw##k)
  #define VFR(i) (bf16x8){vlo[i][0],vlo[i][1],vlo[i][2],vlo[i][3],vhi[i][0],vhi[i][1],vhi[i][2],vhi[i][3]}
  #define PIN(x) asm volatile("":"+v"(x))
  #define MX3(a,b,c) __builtin_fmaxf(__builtin_fmaxf((a),(b)),(c))
  #define GAPA(MF,A0,A1,A2,A3,W0,W1,PW) do{ MF; sacc+=A0; sacc+=A1; sacc+=A2; sacc+=A3; PIN(sacc); W0; W1; PIN(PW); SBAR(); }while(0)
  #define EX(v) __builtin_amdgcn_exp2f(v)
  #define GAPB(MF,X,B,W) do{ MF; X[B]=EX(X[B]); X[B+1]=EX(X[B+1]); X[B+2]=EX(X[B+2]); X[B+3]=EX(X[B+3]); if(MASKED){X[B]=mand(X[B],W,MBIT(B));X[B+1]=mand(X[B+1],W,MBIT(B+1));X[B+2]=mand(X[B+2],W,MBIT(B+2));X[B+3]=mand(X[B+3],W,MBIT(B+3));} PIN(X); SBAR(); }while(0)
  #define VRD(i) do{ vlo[i]=vtr(vp_+(((i)>>2)*4096+((i)&3)*1024)); vhi[i]=vtr(vp_+(((i)>>2)*4096+((i)&3)*1024+512)); }while(0)
  #define KRD(G,j) do{ if(G){ kload2(kf,kp0+sl_next,j); SBAR(); } }while(0)
  #define STEP(C0,C1,P0,P1,t,GK,GV,GL) do{ SBAR(); \
    if(MASKED&&(GV)){ const unsigned vo_=(unsigned)(r32<<10)+8u*(unsigned)((t)+1); asm volatile("global_load_dwordx2 %0, %1, %2":"=&v"(nw):"v"(vo_),"s"(mkw):"memory"); } \
    const lds_cptr vp_=vp0+sl_prev; \
    VRD(0); SBAR(); float sacc=(P0[0]+P0[1]); \
    GAPA(C0=__builtin_amdgcn_mfma_f32_32x32x16_bf16(kf[0],qr[0],negm,0,0,0), P0[2],P0[3],P0[4],P0[5],     pw0[0]=PKW(P0,0), pw0[1]=PKW(P0,2), pw0); \
    VRD(4); SBAR(); GAPA(C1=__builtin_amdgcn_mfma_f32_32x32x16_bf16(kf[1],qr[0],negm,0,0,0), P0[6],P0[7],P0[8],P0[9],     pw0[2]=PKW(P0,4), pw0[3]=PKW(P0,6), pw0); \
    VRD(1); SBAR(); GAPA(C0=__builtin_amdgcn_mfma_f32_32x32x16_bf16(kf[2],qr[1],C0,0,0,0),   P0[10],P0[11],P0[12],P0[13], pw1[0]=PKW(P0,8), pw1[1]=PKW(P0,10), pw1); \
    VRD(5); SBAR(); GAPA(C1=__builtin_amdgcn_mfma_f32_32x32x16_bf16(kf[3],qr[1],C1,0,0,0),   P0[14],P0[15],P1[0],P1[1],   pw1[2]=PKW(P0,12),pw1[3]=PKW(P0,14), pw1); \
    VRD(2); SBAR(); GAPA(C0=__builtin_amdgcn_mfma_f32_32x32x16_bf16(kf[4],qr[2],C0,0,0,0),   P1[2],P1[3],P1[4],P1[5],     pw2[0]=PKW(P1,0), pw2[1]=PKW(P1,2), pw2); \
    VRD(6); SBAR(); GAPA(C1=__builtin_amdgcn_mfma_f32_32x32x16_bf16(kf[5],qr[2],C1,0,0,0),   P1[6],P1[7],P1[8],P1[9],     pw2[2]=PKW(P1,4), pw2[3]=PKW(P1,6), pw2); \
    VRD(3); SBAR(); GAPA(C0=__builtin_amdgcn_mfma_f32_32x32x16_bf16(kf[6],qr[3],C0,0,0,0),   P1[10],P1[11],P1[12],P1[13], pw3[0]=PKW(P1,8), pw3[1]=PKW(P1,10), pw3); \
    VRD(7); SBAR(); GAPA(C1=__builtin_amdgcn_mfma_f32_32x32x16_bf16(kf[7],qr[3],C1,0,0,0),   P1[14],P1[15],0.f,0.f,       pw3[2]=PKW(P1,12),pw3[3]=PKW(P1,14), pw3); \
    l_reg+=sacc; \
    if(GK){DMA_K((t)+3,sl_cur);} if(GV){DMA_V((t)+1,sl_next);} \
    CMASK(C0,C1,t); \
    { float a=MX3(C0[0],C0[1],C1[0]),b=MX3(C0[2],C0[3],C1[1]); a=MX3(a,C1[2],C1[3]); \
      _Pragma("unroll") for(int r=4;r<16;r+=4){a=MX3(a,C0[r],C0[r+1]);b=MX3(b,C0[r+2],C0[r+3]);a=MX3(a,C1[r],C1[r+1]);b=MX3(b,C1[r+2],C1[r+3]);} \
      float rm=__builtin_fmaxf(a,b); { auto rr=__builtin_amdgcn_permlane32_swap(__float_as_uint(rm),__float_as_uint(rm),false,false); rm=__builtin_fmaxf(__uint_as_float(rr[0]),__uint_as_float(rr[1])); } \
      resc=false; \
      if(__builtin_expect(__any(rm>(float)THRL),0)){ const float dl=__builtin_fmaxf(rm,0.f); mhat+=dl; \
        _Pragma("unroll") for(int r=0;r<16;++r){C0[r]-=dl;C1[r]-=dl;} \
        _Pragma("unroll") for(int r=0;r<16;++r)negm[r]=-mhat; asm volatile("":"+v"(negm)); \
        const float f=__builtin_amdgcn_exp2f(-dl); l_reg*=f; if(hi==0)wsf[r32]=f; resc=true; } } \
    SBAR(); \
    GAPB(o[0]=__builtin_amdgcn_mfma_f32_32x32x16_bf16(PAF(0),VFR(0),o[0],0,0,0), C0,0,mlo); \
    GAPB(o[1]=__builtin_amdgcn_mfma_f32_32x32x16_bf16(PAF(0),VFR(4),o[1],0,0,0), C0,4,mlo); \
    KRD(GL,0); GAPB(o[0]=__builtin_amdgcn_mfma_f32_32x32x16_bf16(PAF(1),VFR(1),o[0],0,0,0), C0,8,mlo); \
    KRD(GL,1); GAPB(o[1]=__builtin_amdgcn_mfma_f32_32x32x16_bf16(PAF(1),VFR(5),o[1],0,0,0), C0,12,mlo); \
    KRD(GL,2); GAPB(o[0]=__builtin_amdgcn_mfma_f32_32x32x16_bf16(PAF(2),VFR(2),o[0],0,0,0), C1,0,mhi); \
    KRD(GL,3); GAPB(o[1]=__builtin_amdgcn_mfma_f32_32x32x16_bf16(PAF(2),VFR(6),o[1],0,0,0), C1,4,mhi); \
    GAPB(o[0]=__builtin_amdgcn_mfma_f32_32x32x16_bf16(PAF(3),VFR(3),o[0],0,0,0), C1,8,mhi); \
    GAPB(o[1]=__builtin_amdgcn_mfma_f32_32x32x16_bf16(PAF(3),VFR(7),o[1],0,0,0), C1,12,mhi); \
    }while(0)
  int t=1;
  #undef CMASK
  #define CMASK(P0,P1,t) do{}while(0)
  for(;t+5<NT;t+=2){
    STEP(pB0,pB1,pA0,pA1,t,true,true,true);     WAIT_BAR(2); MROT(); RESC(); ROT();
    STEP(pA0,pA1,pB0,pB1,t+1,true,true,true);   WAIT_BAR(2); MROT(); RESC(); ROT();
  }
  #undef CMASK
  #define CMASK(P0,P1,t) do{ if(!MASKED){ int jb_=(t)-(NT-4); if(jb_>=0)cmask(P0,P1,jb_,qrel,hi);} }while(0)
  #define ENDW(tt) do{ if((tt)+3<NT){WAIT_BAR(2);} else if((tt)+2<NT){WAIT_BAR(1);} else {WAIT_BAR(0);} }while(0)
  for(;t+1<NT;t+=2){
    STEP(pB0,pB1,pA0,pA1,t,(t+3<NT),(t+1<NT),(t+1<NT));       ENDW(t);   MROT(); RESC(); ROT();
    STEP(pA0,pA1,pB0,pB1,t+1,(t+4<NT),(t+2<NT),(t+2<NT));     ENDW(t+1); MROT(); RESC(); ROT();
  }
  STEP(pB0,pB1,pA0,pA1,NT-1,false,false,false); RESC();
  { float sacc=pB0[0]+pB0[1]; _Pragma("unroll") for(int r=2;r<16;++r)sacc+=pB0[r]; _Pragma("unroll") for(int r=0;r<16;++r)sacc+=pB1[r]; l_reg+=sacc;
    pw0=(u32x4){PKW(pB0,0),PKW(pB0,2),PKW(pB0,4),PKW(pB0,6)};pw1=(u32x4){PKW(pB0,8),PKW(pB0,10),PKW(pB0,12),PKW(pB0,14)};pw2=(u32x4){PKW(pB1,0),PKW(pB1,2),PKW(pB1,4),PKW(pB1,6)};pw3=(u32x4){PKW(pB1,8),PKW(pB1,10),PKW(pB1,12),PKW(pB1,14)};
    SBAR(); pv(o,vb0+sl_cur,PAF(0),PAF(1),PAF(2),PAF(3)); }
  #undef PKW
  #undef PAF
  #undef VFR
  #undef PIN
  #undef MX3
  #undef GAPA
  #undef GAPB
  #undef EX
  #undef VRD
  #undef KRD
  #undef STEP
  #undef ENDW
  #undef MROT
  {auto rr=__builtin_amdgcn_permlane32_swap(__float_as_uint(l_reg),__float_as_uint(l_reg),false,false);l_reg=__uint_as_float(rr[0])+__uint_as_float(rr[1]);}
  if(hi==0)wsf[32+r32]=l_reg;asm volatile("s_waitcnt lgkmcnt(0)":::"memory");
  float rli[16];
  #pragma unroll
  for(int r=0;r<16;++r)rli[r]=__builtin_amdgcn_rcpf(wsf[32+crow(r,hi)]);
  bf16*Ow=O+(rowbase+q0+wid*QBLK)*OP;
  { bf16*stg=(bf16*)(shm+LDS_OST)+wid*2048;
    #pragma unroll
    for(int r=0;r<16;++r){const int orow=crow(r,hi);
      #pragma unroll
      for(int d0=0;d0<2;++d0)stg[orow*64+d0*32+r32]=__float2bfloat16(o[d0][r]*rli[r]);}
    asm volatile("s_waitcnt lgkmcnt(0)":::"memory");
    #pragma unroll
    for(int i=0;i<4;++i){const int row=i*8+(lane>>3),ch=lane&7; const u32x4 v=*(const u32x4*)(stg+row*64+ch*8); ATTN_STORE16(Ow+(long)row*OP+ch*8,v);} }
  asm volatile("s_waitcnt lgkmcnt(0)\n\ts_barrier":::"memory");
  #undef DMA_K
  #undef DMA_V
  #undef CMASK
  #undef START
  #undef RESC
  #undef ROT
}
constexpr int ATTN_LDS_BYTES=LDS_BYTES;
#undef SBAR
#undef WAIT_BAR
}
constexpr int IX_SLOT = 8288;
constexpr int IX_BINS = 384;
constexpr int IX_HC_OFF = 4 * IX_SLOT * 4;
constexpr int IX_HC_ROW = 2048, IX_CAP = 256;
constexpr int IX_MB_OFF = IX_HC_OFF + 8 * IX_HC_ROW;
constexpr int IX_CNT_OFF = IX_MB_OFF + 8 * 128 * 8;
constexpr int IX_MM_OFF = IX_CNT_OFF + 32;
constexpr int IX_LDS = IX_MM_OFF + 64;
DI int ix_bin(float x, float lo, float scale) { const int b = (int)((x - lo) * scale); return b > IX_BINS - 1 ? IX_BINS - 1 : b; }
DI float fkey_inv(unsigned k) { return __uint_as_float((k & 0x80000000u) ? (k & 0x7fffffffu) : ~k); }

DI void index_phase(unsigned char* ws, char* ldsc, int G, int bx, const int wid_s, const int sub) {
    const int lane = lane_id_asm(), wid = wid_s, r32 = lane & 31, hi = lane >> 5;
    float* sc = (float*)ldsc;
    char* hcA = ldsc + IX_HC_OFF;
    unsigned* mb32 = (unsigned*)(ldsc + IX_MB_OFF);
    unsigned* cntA = (unsigned*)(ldsc + IX_CNT_OFF);
    unsigned* mmA = (unsigned*)(ldsc + IX_MM_OFF);
    const bf16_t* QI = (const bf16_t*)(ws + WS_QI); const bf16_t* KI = (const bf16_t*)(ws + WS_KI); const float* WI = (const float*)(ws + WS_WI);
    u64* MASK = (u64*)(ws + WS_MASK);
    for (int i = lane; i < IX_BINS; i += 64) ((unsigned*)(hcA + wid * IX_HC_ROW))[i] = 0u;
    for (int i = lane; i < 256; i += 64) mb32[wid * 256 + i] = 0u;
    if (lane == 0) { cntA[wid] = 0u; mmA[2 * wid] = 0xFFFFFFFFu; mmA[2 * wid + 1] = 0u; }
    __syncthreads();
    for (int item = bx; item < 2048; item += G) {
        const int b = item >> 10, j = item & 1023, gA = 2047 - j, gB = j, rowbase = b * S;
        const int nA = 4 * gA + 4, nB = 4 * gB + 4, offB = (nA + 63) & ~63;
        {
            bf16x8 qa0, qa1, qb0, qb1; float wa[16], wb[16];
            { const int row = r32 & 3, head = r32 >> 2;
              const bf16_t* pa = QI + (size_t)(rowbase + 4 * gA + row) * 256 + head * 32 + 8 * hi; qa0 = *(const bf16x8*)pa; qa1 = *(const bf16x8*)(pa + 16);
              const bf16_t* pb = QI + (size_t)(rowbase + 4 * gB + row) * 256 + head * 32 + 8 * hi; qb0 = *(const bf16x8*)pb; qb1 = *(const bf16x8*)(pb + 16); }
#pragma unroll
            for (int jj = 0; jj < 4; ++jj)
#pragma unroll
                for (int row = 0; row < 4; ++row) {
                    wa[4 * jj + row] = WI[(size_t)(rowbase + 4 * gA + row) * 8 + 2 * jj + hi];
                    wb[4 * jj + row] = WI[(size_t)(rowbase + 4 * gB + row) * 8 + 2 * jj + hi];
                }
            const int ntAr = (nA + 31) >> 5, ntB = (nB + 31) >> 5;
            const f32x16 zero = {};
            float mnA0 = INFINITY, mnA1 = INFINITY, mxA0 = -INFINITY, mxA1 = -INFINITY, mnB0 = INFINITY, mnB1 = INFINITY, mxB0 = -INFINITY, mxB1 = -INFINITY;
            const bf16_t* kp = KI + (size_t)(rowbase + 32 * wid + r32) * 32 + 8 * hi;
            bf16x8 k0 = *(const bf16x8*)kp, k1 = *(const bf16x8*)(kp + 16);
            for (int k = wid; k < ntAr; k += 8) {
                const bf16x8 c0 = k0, c1 = k1;
                kp += 8 * 32 * 32;
                if (k + 8 < ntAr) { k0 = *(const bf16x8*)kp; k1 = *(const bf16x8*)(kp + 16); }
                const int key = 32 * k + r32;
                {
                    f32x16 acc = MFMA32(qa0, c0, zero); acc = MFMA32(qa1, c1, acc);
                    float s[4];
#pragma unroll
                    for (int row = 0; row < 4; ++row) {
                        float t = wa[row] * fmaxf(acc[row], 0.f);
                        t += wa[4 + row] * fmaxf(acc[4 + row], 0.f); t += wa[8 + row] * fmaxf(acc[8 + row], 0.f); t += wa[12 + row] * fmaxf(acc[12 + row], 0.f);
                        const auto rr = __builtin_amdgcn_permlane32_swap(__float_as_uint(t), __float_as_uint(t), false, false);
                        s[row] = (__uint_as_float(rr[0]) + __uint_as_float(rr[1])) + 0.0f;
                    }
                    const float v0 = hi ? s[2] : s[0], v1 = hi ? s[3] : s[1];
                    sc[(2 * hi) * IX_SLOT + key] = v0; sc[(2 * hi + 1) * IX_SLOT + key] = v1;
                    mnA0 = fminf(mnA0, v0); mxA0 = fmaxf(mxA0, v0); mnA1 = fminf(mnA1, v1); mxA1 = fmaxf(mxA1, v1);
                }
                if (k < ntB) {
                    f32x16 acc = MFMA32(qb0, c0, zero); acc = MFMA32(qb1, c1, acc);
                    float s[4];
#pragma unroll
                    for (int row = 0; row < 4; ++row) {
                        float t = wb[row] * fmaxf(acc[row], 0.f);
                        t += wb[4 + row] * fmaxf(acc[4 + row], 0.f); t += wb[8 + row] * fmaxf(acc[8 + row], 0.f); t += wb[12 + row] * fmaxf(acc[12 + row], 0.f);
                        const auto rr = __builtin_amdgcn_permlane32_swap(__float_as_uint(t), __float_as_uint(t), false, false);
                        s[row] = (__uint_as_float(rr[0]) + __uint_as_float(rr[1])) + 0.0f;
                    }
                    const float v0 = hi ? s[2] : s[0], v1 = hi ? s[3] : s[1];
                    sc[(2 * hi) * IX_SLOT + offB + key] = v0; sc[(2 * hi + 1) * IX_SLOT + offB + key] = v1;
                    mnB0 = fminf(mnB0, v0); mxB0 = fmaxf(mxB0, v0); mnB1 = fminf(mnB1, v1); mxB1 = fmaxf(mxB1, v1);
                }
            }
#pragma unroll
            for (int o = 1; o < 32; o <<= 1) {
                mnA0 = fminf(mnA0, __shfl_xor(mnA0, o)); mxA0 = fmaxf(mxA0, __shfl_xor(mxA0, o)); mnA1 = fminf(mnA1, __shfl_xor(mnA1, o)); mxA1 = fmaxf(mxA1, __shfl_xor(mxA1, o));
                mnB0 = fminf(mnB0, __shfl_xor(mnB0, o)); mxB0 = fmaxf(mxB0, __shfl_xor(mxB0, o)); mnB1 = fminf(mnB1, __shfl_xor(mnB1, o)); mxB1 = fmaxf(mxB1, __shfl_xor(mxB1, o));
            }
            if (r32 == 0) {
                atomicMin(&mmA[2 * (2 * hi)], fkey(mnA0)); atomicMax(&mmA[2 * (2 * hi) + 1], fkey(mxA0)); atomicMin(&mmA[2 * (2 * hi + 1)], fkey(mnA1)); atomicMax(&mmA[2 * (2 * hi + 1) + 1], fkey(mxA1));
                atomicMin(&mmA[2 * (4 + 2 * hi)], fkey(mnB0)); atomicMax(&mmA[2 * (4 + 2 * hi) + 1], fkey(mxB0)); atomicMin(&mmA[2 * (5 + 2 * hi)], fkey(mnB1)); atomicMax(&mmA[2 * (5 + 2 * hi) + 1], fkey(mxB1));
            }
        }
        __syncthreads();
        if (!(sub & 4)) {
            const int p = wid & 3, h = wid >> 2;
            int bst[2] = {0, 0};
#pragma unroll
            for (int ab = 0; ab < 2 && !(sub & 8); ++ab) {
                const int row = 4 * ab + p, n = 4 * (ab ? gB : gA) + p + 1;
                if (n > 256) {
                    const float* base = sc + p * IX_SLOT + (ab ? offB : 0);
                    const float lo = fkey_inv(mmA[2 * row]), hv = fkey_inv(mmA[2 * row + 1]);
                    const float scale = (hv > lo) ? (float)IX_BINS / (hv - lo) : 0.f;
                    unsigned* hist = (unsigned*)(hcA + row * IX_HC_ROW);
#pragma unroll 2
                    for (int i = 256 * h + lane * 4; i < n; i += 512) {
                        const f32x4 v = *(const f32x4*)(base + i);
#pragma unroll
                        for (int e = 0; e < 4; ++e) if (i + e < n) __hip_atomic_fetch_add(&hist[ix_bin(v[e], lo, scale)], 1u, __ATOMIC_RELAXED, __HIP_MEMORY_SCOPE_WORKGROUP);
                    }
                }
            }
            __syncthreads();
#pragma unroll
            for (int ab = 0; ab < 2 && !(sub & 16); ++ab) {
                const int row = 4 * ab + p, n = 4 * (ab ? gB : gA) + p + 1;
                if (n > 256) {
                    const unsigned* hist = (const unsigned*)(hcA + row * IX_HC_ROW);
                    unsigned hc[6];
#pragma unroll
                    for (int e = 0; e < 6; ++e) hc[e] = hist[6 * lane + e];
                    unsigned Ssum = (hc[0] + hc[1]) + (hc[2] + hc[3]) + (hc[4] + hc[5]);
#pragma unroll
                    for (int o = 1; o < 64; o <<= 1) { const unsigned v = __shfl_down(Ssum, o); if (lane + o < 64) Ssum += v; }
                    const u64 balS = __ballot(Ssum >= 256u);
                    const int Ls = 63 - __clzll((long long)balS);
                    const unsigned Snext = __shfl_down(Ssum, 1);
                    unsigned cum = (lane < 63) ? Snext : 0u; int bsel = 0; bool found = false;
#pragma unroll
                    for (int e = 5; e >= 0; --e) { if (!found) { if (cum + hc[e] >= 256u) { bsel = 6 * lane + e; found = true; } else cum += hc[e]; } }
                    bst[ab] = __shfl(bsel, Ls);
                }
            }
            __syncthreads();
#pragma unroll
            for (int ab = 0; ab < 2 && !(sub & 16); ++ab) {
                const int row = 4 * ab + p, n = 4 * (ab ? gB : gA) + p + 1;
                const float* base = sc + p * IX_SLOT + (ab ? offB : 0);
                u64* mb = (u64*)(mb32 + row * 256);
                if (n > 256) {
                    const float lo = fkey_inv(mmA[2 * row]), hv = fkey_inv(mmA[2 * row + 1]);
                    const float scale = (hv > lo) ? (float)IX_BINS / (hv - lo) : 0.f;
                    const int bstar = bst[ab];
                    uint2* clist = (uint2*)(hcA + row * IX_HC_ROW);
                    for (int c0 = 256 * h; c0 < n; c0 += 512) {
                        float xv[4];
#pragma unroll
                        for (int u = 0; u < 4; ++u) { const int i = c0 + 64 * u + lane; xv[u] = (i < n) ? base[i] : 0.f; }
#pragma unroll
                        for (int u = 0; u < 4; ++u) {
                            const int i = c0 + 64 * u + lane;
                            if (c0 + 64 * u < n) {
                                const int bn = (i < n) ? ix_bin(xv[u], lo, scale) : -1;
                                const u64 bsel64 = __ballot(bn > bstar), bcand = __ballot(bn == bstar);
                                if (lane == 0) mb[(c0 >> 6) + u] = bsel64;
                                if (bcand) {
                                    unsigned pos0 = 0u; if (lane == 0) pos0 = atomicAdd(&cntA[row], (unsigned)__popcll(bcand));
                                    pos0 = __shfl(pos0, 0);
                                    if (bn == bstar) { const unsigned pos = pos0 + (unsigned)__popcll(bcand & ((1ull << lane) - 1ull)); if (pos < (unsigned)IX_CAP) clist[pos] = make_uint2(fkey(xv[u]), (unsigned)i); }
                                }
                            }
                        }
                    }
                } else if (h == 0) {
                    if (lane < 4) { const int lo64 = 64 * lane; mb[lane] = (n - lo64 >= 64) ? ~0ull : (n > lo64 ? ((1ull << (n - lo64)) - 1ull) : 0ull); }
                }
            }
            __syncthreads();
            if (!(sub & 32)) {
                const int row = wid, slot = wid & 3, isB = wid >> 2, t = 4 * (isB ? gB : gA) + slot, n = t + 1;
                const float* base = sc + slot * IX_SLOT + (isB ? offB : 0);
                const size_t R = (size_t)rowbase + t;
                const int nw_all = 4 * (t >> 8) + 4;
                unsigned* mbr = mb32 + row * 256; u64* mb = (u64*)mbr;
                if (n > 256) {
                    const int m = (int)cntA[row];
                    unsigned above = 0u;
                    { const u64 w0 = mb[lane], w1 = mb[64 + lane]; above = (unsigned)(__popcll(w0) + __popcll(w1)); above = wave_sum_u(above); }
                    const int need = 256 - (int)above;
                    uint2* clist = (uint2*)(hcA + row * IX_HC_ROW);
                    if (m <= IX_CAP) {
                        unsigned mu[4], mk[4]; int rank[4];
#pragma unroll
                        for (int q = 0; q < 4; ++q) { mu[q] = 0u; mk[q] = 0u; rank[q] = 0; if (lane + 64 * q < m) { const uint2 e = clist[lane + 64 * q]; mu[q] = e.x; mk[q] = e.y; } }
                        for (int jx = 0; jx < m; ++jx) {
                            const uint2 e = clist[jx];
#pragma unroll
                            for (int q = 0; q < 4; ++q) rank[q] += ((e.x > mu[q]) || (e.x == mu[q] && e.y < mk[q])) ? 1 : 0;
                        }
#pragma unroll
                        for (int q = 0; q < 4; ++q) if (lane + 64 * q < m && rank[q] < need) atomicOr(&mbr[mk[q] >> 5], 1u << (mk[q] & 31u));
                    } else if (!(sub & 64)) {
                        const int bstar = isB ? bst[1] : bst[0];
                        const float lo = fkey_inv(mmA[2 * row]), hv = fkey_inv(mmA[2 * row + 1]);
                        const float scale = (hv > lo) ? (float)IX_BINS / (hv - lo) : 0.f;
                        unsigned* hist = (unsigned*)(hcA + row * IX_HC_ROW); uint2* clist2 = (uint2*)(hcA + row * IX_HC_ROW + IX_BINS * 4);
                        for (int i = lane; i < IX_BINS; i += 64) hist[i] = 0u;
                        __builtin_amdgcn_fence(__ATOMIC_ACQ_REL, "workgroup");
#pragma unroll 2
                        for (int i = lane * 4; i < n; i += 256) {
                            const f32x4 v = *(const f32x4*)(base + i);
#pragma unroll
                            for (int e = 0; e < 4; ++e) if (i + e < n) {
                                const float tt = (v[e] - lo) * scale; const int bn = (int)tt > IX_BINS - 1 ? IX_BINS - 1 : (int)tt;
                                if (bn == bstar) { const int sb = (int)((tt - (float)bstar) * (float)IX_BINS); __hip_atomic_fetch_add(&hist[sb > IX_BINS - 1 ? IX_BINS - 1 : sb], 1u, __ATOMIC_RELAXED, __HIP_MEMORY_SCOPE_WORKGROUP); }
                            }
                        }
                        __builtin_amdgcn_fence(__ATOMIC_ACQ_REL, "workgroup");
                        unsigned hc[6];
#pragma unroll
                        for (int e = 0; e < 6; ++e) hc[e] = hist[6 * lane + e];
                        unsigned Ssum = (hc[0] + hc[1]) + (hc[2] + hc[3]) + (hc[4] + hc[5]);
#pragma unroll
                        for (int o = 1; o < 64; o <<= 1) { const unsigned v = __shfl_down(Ssum, o); if (lane + o < 64) Ssum += v; }
                        const u64 balS = __ballot(Ssum >= (unsigned)need);
                        const int Ls = 63 - __clzll((long long)balS);
                        const unsigned Snext = __shfl_down(Ssum, 1);
                        unsigned cum = (lane < 63) ? Snext : 0u; int bsel = 0; unsigned abv = 0u; bool found = false;
#pragma unroll
                        for (int e = 5; e >= 0; --e) { if (!found) { if (cum + hc[e] >= (unsigned)need) { bsel = 6 * lane + e; abv = cum; found = true; } else cum += hc[e]; } }
                        const int b2 = __shfl(bsel, Ls); const int need2 = need - (int)__shfl(abv, Ls);
                        int m2 = 0;
                        for (int c0 = 0; c0 < n; c0 += 64) {
                            const int i = c0 + lane; const float xx = (i < n) ? base[i] : 0.f;
                            const float tt = (xx - lo) * scale; const int bn = (int)tt > IX_BINS - 1 ? IX_BINS - 1 : (int)tt;
                            int sb = (int)((tt - (float)bstar) * (float)IX_BINS); sb = sb > IX_BINS - 1 ? IX_BINS - 1 : sb;
                            const bool inb = (i < n) && bn == bstar;
                            const u64 bup = __ballot(inb && sb > b2), bcd = __ballot(inb && sb == b2);
                            if (lane == 0 && bup) mb[c0 >> 6] |= bup;
                            if (inb && sb == b2) { const int pos = m2 + __popcll(bcd & ((1ull << lane) - 1ull)); if (pos < 64) clist2[pos] = make_uint2(fkey(xx), (unsigned)i); }
                            m2 += __popcll(bcd);
                        }
                        __builtin_amdgcn_fence(__ATOMIC_ACQ_REL, "workgroup");
                        if (m2 <= 64) {
                            unsigned mu = 0u, mk = 0u; if (lane < m2) { const uint2 e = clist2[lane]; mu = e.x; mk = e.y; }
                            int rank = 0;
                            for (int jx = 0; jx < m2; ++jx) { const unsigned uj = __shfl(mu, jx), kj = __shfl(mk, jx); rank += ((uj > mu) || (uj == mu && kj < mk)) ? 1 : 0; }
                            if (lane < m2 && rank < need2) atomicOr(&mbr[mk >> 5], 1u << (mk & 31u));
                        } else {
                            unsigned Tb = 0u;
                            for (int bit = 31; bit >= 0; --bit) {
                                const unsigned cd = Tb | (1u << bit); unsigned c = 0u;
                                for (int i = lane; i < n; i += 64) c += (fkey(base[i]) >= cd) ? 1u : 0u;
                                if (wave_sum_u(c) >= 256u) Tb = cd;
                            }
                            unsigned cg = 0u; for (int i = lane; i < n; i += 64) cg += (fkey(base[i]) > Tb) ? 1u : 0u;
                            const unsigned nd = 256u - wave_sum_u(cg);
                            int lk = 0, hk = n - 1;
                            while (lk < hk) { const int mid = (lk + hk) >> 1; unsigned c = 0u; for (int i = lane; i <= mid; i += 64) c += (fkey(base[i]) == Tb) ? 1u : 0u; if (wave_sum_u(c) >= nd) hk = mid; else lk = mid + 1; }
                            for (int c = 0; 64 * c < n; ++c) {
                                const int i = 64 * c + lane; const unsigned uk = (i < n) ? fkey(base[i]) : 0u;
                                const u64 bal = __ballot((i < n) && (uk > Tb || (uk == Tb && i <= lk)));
                                if (lane == 0) mb[c] = bal;
                            }
                        }
                    }
                }
                __builtin_amdgcn_fence(__ATOMIC_ACQ_REL, "workgroup");
                { const u64 w0 = mb[lane], w1 = mb[64 + lane];
                  if (lane < nw_all) MASK[R * 128 + lane] = w0;
                  if (64 + lane < nw_all) MASK[R * 128 + 64 + lane] = w1; }
                for (int i = lane; i < IX_BINS; i += 64) ((unsigned*)(hcA + row * IX_HC_ROW))[i] = 0u;
                for (int i = lane; i < 256; i += 64) mbr[i] = 0u;
                if (lane == 0) { cntA[row] = 0u; mmA[2 * row] = 0xFFFFFFFFu; mmA[2 * row + 1] = 0u; }
            }
        }
        __syncthreads();
    }
}
#define XB_TMO      128
#define XB_XCNT(j)  (256  + 64 * (j))
#define XB_XSUB(j)  (1280 + 64 * (j))
#define XB_XGEN(j)  (2304 + 64 * (j))
#define XB_TOP      3328
#define XB_TOPGEN   3392
#define XCD_BAR_WORDS 3456
#define XB_SPIN_CAP (1u << 18)
#define LAS __attribute__((address_space(3)))

__device__ __forceinline__ unsigned xb_ld(unsigned* p)              { return __hip_atomic_load(p, __ATOMIC_RELAXED, __HIP_MEMORY_SCOPE_AGENT); }
__device__ __forceinline__ unsigned xb_add(unsigned* p, unsigned v) { return __hip_atomic_fetch_add(p, v, __ATOMIC_RELAXED, __HIP_MEMORY_SCOPE_AGENT); }
__device__ __forceinline__ unsigned xb_xcc_id() { return (unsigned)__builtin_amdgcn_s_getreg((3 << 11) | 20) & 0xFu; }
#define XB_SPIN(cond, bar) do { unsigned _sp = 0; while (cond) { __builtin_amdgcn_s_sleep(1); \
    if ((++_sp & 255u) == 0u) { if (xb_ld(&(bar)[XB_TMO])) break; if (_sp > XB_SPIN_CAP) { atomicAdd(&(bar)[XB_TMO], 1u); break; } } } } while (0)

struct XcdBarrier {
    unsigned* bar; unsigned x;
    volatile LAS unsigned* st;
};

__device__ __forceinline__ XcdBarrier xcd_barrier_post(unsigned* bar, volatile LAS unsigned* st, bool leader) {
    XcdBarrier b; b.bar = bar; b.x = xb_xcc_id(); b.st = st;
    if (leader) (void)xb_add(&bar[XB_XCNT(b.x)], 1u);
    return b;
}
__device__ __forceinline__ void xcd_barrier_complete(unsigned* bar, unsigned x, unsigned& nloc, unsigned& nx) {
    const unsigned G = gridDim.x * gridDim.y * gridDim.z;
    unsigned sum, cnt, mine, sp = 0u;
    for (;;) {
        sum = 0u; cnt = 0u; mine = 0u;
#pragma unroll
        for (unsigned j = 0; j < 16; ++j) { const unsigned c = xb_ld(&bar[XB_XCNT(j)]); sum += c; cnt += (c > 0u) ? 1u : 0u; mine = (j == x) ? c : mine; }
        if (sum == G) break;
        __builtin_amdgcn_s_sleep(1);
        if ((++sp & 255u) == 0u) { if (xb_ld(&bar[XB_TMO])) break; if (sp > XB_SPIN_CAP) { atomicAdd(&bar[XB_TMO], 1u); break; } }
    }
    nloc = mine > 0u ? mine : 1u; nx = cnt > 0u ? cnt : 1u;
}

__device__ __forceinline__ void xcd_barrier(const XcdBarrier& b, bool leader) {
    asm volatile("s_waitcnt vmcnt(0)" ::: "memory");
    __syncthreads();
    if (leader) {
        unsigned* bar = b.bar;
        __builtin_amdgcn_s_waitcnt(0);
        unsigned nloc = b.st[0], nx = b.st[1];
        if (nloc == 0u) { xcd_barrier_complete(bar, b.x, nloc, nx); b.st[0] = nloc; b.st[1] = nx; }
        const unsigned old = xb_add(&bar[XB_XSUB(b.x)], 1u);
        const unsigned gen = old / nloc;
        if (old + 1u == (gen + 1u) * nloc) {
            __builtin_amdgcn_fence(__ATOMIC_RELEASE, "agent");
            asm volatile("s_waitcnt vmcnt(0)" ::: "memory");
            const unsigned og = xb_add(&bar[XB_TOP], 1u);
            const unsigned tg = og / nx;
            if (og + 1u == (tg + 1u) * nx) xb_add(&bar[XB_TOPGEN], 1u);
            else XB_SPIN(xb_ld(&bar[XB_TOPGEN]) == tg, bar);
            __builtin_amdgcn_fence(__ATOMIC_ACQUIRE, "agent");
            xb_add(&bar[XB_XGEN(b.x)], 1u);
            asm volatile("s_waitcnt vmcnt(0)" ::: "memory");
        } else {
            XB_SPIN(xb_ld(&bar[XB_XGEN(b.x)]) == gen, bar);
            __builtin_amdgcn_fence(__ATOMIC_ACQUIRE, "agent");
            asm volatile("s_waitcnt vmcnt(0)" ::: "memory");
        }
    }
    __syncthreads();
}

using pg8::Unit;
typedef float f32x2_t __attribute__((ext_vector_type(2))); typedef __bf16 bf16x2_t __attribute__((ext_vector_type(2)));
DI unsigned cvtpk(float lo, float hi) { f32x2_t v = {lo, hi}; bf16x2_t b = __builtin_convertvector(v, bf16x2_t); return __builtin_bit_cast(unsigned, b); }
DI u32x4 pack8(const f32x4& a, const f32x4& b) { u32x4 w; w.x = cvtpk(a[0], a[1]); w.y = cvtpk(a[2], a[3]); w.z = cvtpk(b[0], b[1]); w.w = cvtpk(b[2], b[3]); return w; }
DI void unpack8(const u32x4& w, f32x4& a, f32x4& b) {
    a[0] = __uint_as_float(w.x << 16); a[1] = __uint_as_float(w.x & 0xffff0000u); a[2] = __uint_as_float(w.y << 16); a[3] = __uint_as_float(w.y & 0xffff0000u);
    b[0] = __uint_as_float(w.z << 16); b[1] = __uint_as_float(w.z & 0xffff0000u); b[2] = __uint_as_float(w.w << 16); b[3] = __uint_as_float(w.w & 0xffff0000u);
}
DI float sigmoidf_(float v) { return __builtin_amdgcn_rcpf(1.0f + __expf(-v)); }

struct EpiIn {
    static constexpr bool PERM = true, AFTER_DRAIN = false;
    unsigned char* ws; const float* ki_g; const float* ki_b; const float* gate_b;
    DI void operator()(const f32x4 (&acc)[2][2][4][2], const Unit& u, int wr, int wc, int fr, int fq) const {
        const int pn = u.pn, row0 = u.pm * 256 + wr * 64 + fr, cl0 = wc * 32 + 8 * fq;
        if (pn < 12) {
            const int seg = pn >> 1, kind = seg % 3;
            bf16_t* O = (bf16_t*)(ws + WS_QA + (size_t)seg * 16 * MiB) + (pn & 1) * 256 + cl0;
            const bool ropew = (kind != 2) && ((wc & 1) == 0);
            const float sc = (kind == 0) ? C2 : 1.0f, sg = (fq == 0) ? -1.0f : 1.0f;
            const float2* RH = (const float2*)(ws + WS_ROPE_H);
#pragma unroll
            for (int ai = 0; ai < 2; ++ai)
#pragma unroll
                for (int m = 0; m < 4; ++m) {
                    const int row = row0 + ai * 128 + m * 16;
                    f32x4 cs4[4];
                    if (ropew) { const f32x4* p = (const f32x4*)(RH + (size_t)row * 8); cs4[0] = p[0]; cs4[1] = p[1]; cs4[2] = p[2]; cs4[3] = p[3]; }
#pragma unroll
                    for (int bj = 0; bj < 2; ++bj) {
                        f32x4 v0 = acc[ai][bj][m][0], v1 = acc[ai][bj][m][1];
                        if (ropew) {
                            f32x4 p0, p1;
#pragma unroll
                            for (int i = 0; i < 4; ++i) { p0[i] = __shfl_xor(v0[i], 16); p1[i] = __shfl_xor(v1[i], 16); }
                            if (fq < 2) {
#pragma unroll
                                for (int i = 0; i < 4; ++i) {
                                    v0[i] = v0[i] * cs4[i >> 1][(i & 1) * 2] + sg * p0[i] * cs4[i >> 1][(i & 1) * 2 + 1];
                                    v1[i] = v1[i] * cs4[2 + (i >> 1)][(i & 1) * 2] + sg * p1[i] * cs4[2 + (i >> 1)][(i & 1) * 2 + 1];
                                }
                            }
                        }
                        v0 = v0 * sc; v1 = v1 * sc;
                        *(u32x4*)(O + (size_t)row * 512 + 128 * bj) = pack8(v0, v1);
                    }
                }
        } else if (pn == 12) {
            bf16_t* O = (bf16_t*)(ws + WS_QI) + cl0; const float2* RI = (const float2*)(ws + WS_ROPE_I);
#pragma unroll
            for (int ai = 0; ai < 2; ++ai)
#pragma unroll
                for (int m = 0; m < 4; ++m) {
                    const int row = row0 + ai * 128 + m * 16;
                    f32x4 ci[2];
                    if (fq == 0) { const f32x4* p = (const f32x4*)(RI + (size_t)row * 4); ci[0] = p[0]; ci[1] = p[1]; }
#pragma unroll
                    for (int bj = 0; bj < 2; ++bj) {
                        f32x4 v0 = acc[ai][bj][m][0], v1 = acc[ai][bj][m][1];
                        if (fq == 0) {
#pragma unroll
                            for (int i = 0; i < 4; ++i) { const float c = ci[i >> 1][(i & 1) * 2], s = ci[i >> 1][(i & 1) * 2 + 1], a = v0[i], b = v1[i]; v0[i] = a * c - b * s; v1[i] = b * c + a * s; }
                        }
                        *(u32x4*)(O + (size_t)row * 256 + 128 * bj) = pack8(v0, v1);
                    }
                }
        } else if (pn == 13) {
            if (wc == 0) {
                bf16_t* KI = (bf16_t*)(ws + WS_KI) + 8 * fq; const float2* RI = (const float2*)(ws + WS_ROPE_I);
                const f32x4 g0 = *(const f32x4*)(ki_g + 8 * fq), g1 = *(const f32x4*)(ki_g + 8 * fq + 4), b0 = *(const f32x4*)(ki_b + 8 * fq), b1 = *(const f32x4*)(ki_b + 8 * fq + 4);
#pragma unroll
                for (int ai = 0; ai < 2; ++ai)
#pragma unroll
                    for (int m = 0; m < 4; ++m) {
                        const int row = row0 + ai * 128 + m * 16;
                        f32x4 v0 = acc[ai][0][m][0], v1 = acc[ai][0][m][1];
                        float s = (v0[0] + v0[1]) + (v0[2] + v0[3]) + (v1[0] + v1[1]) + (v1[2] + v1[3]);
                        s += __shfl_xor(s, 16); s += __shfl_xor(s, 32);
                        const float mu = s * (1.0f / 32.0f);
                        v0 = v0 - mu; v1 = v1 - mu;
                        float q = (v0[0] * v0[0] + v0[1] * v0[1]) + (v0[2] * v0[2] + v0[3] * v0[3]) + (v1[0] * v1[0] + v1[1] * v1[1]) + (v1[2] * v1[2] + v1[3] * v1[3]);
                        q += __shfl_xor(q, 16); q += __shfl_xor(q, 32);
                        const float rs = 1.0f / sqrtf(q * (1.0f / 32.0f) + 1e-6f);
                        v0 = v0 * rs * g0 + b0; v1 = v1 * rs * g1 + b1;
                        if (fq == 0) {
                            const f32x4* p = (const f32x4*)(RI + (size_t)row * 4); const f32x4 c0 = p[0], c1 = p[1];
#pragma unroll
                            for (int i = 0; i < 4; ++i) { const float c = (i < 2 ? c0 : c1)[(i & 1) * 2], sn = (i < 2 ? c0 : c1)[(i & 1) * 2 + 1], a = v0[i], b = v1[i]; v0[i] = a * c - b * sn; v1[i] = b * c + a * sn; }
                        }
                        *(u32x4*)(KI + (size_t)row * 32) = pack8(v0, v1);
                    }
            } else if (wc == 1) {
                float* WI = (float*)(ws + WS_WI);
                if (fq == 0) {
#pragma unroll
                    for (int ai = 0; ai < 2; ++ai)
#pragma unroll
                        for (int m = 0; m < 4; ++m) {
                            const int row = row0 + ai * 128 + m * 16;
                            *(f32x4*)(WI + (size_t)row * 8) = acc[ai][0][m][0] * (1.0f / 16.0f); *(f32x4*)(WI + (size_t)row * 8 + 4) = acc[ai][0][m][1] * (1.0f / 16.0f);
                        }
                }
            }
        } else {
            const int cg0 = 256 * (pn - 14) + cl0; bf16_t* G = (bf16_t*)(ws + WS_G) + cg0;
#pragma unroll
            for (int bj = 0; bj < 2; ++bj) {
                const f32x4 gb0 = *(const f32x4*)(gate_b + cg0 + 128 * bj), gb1 = *(const f32x4*)(gate_b + cg0 + 128 * bj + 4);
#pragma unroll
                for (int ai = 0; ai < 2; ++ai)
#pragma unroll
                    for (int m = 0; m < 4; ++m) {
                        const int row = row0 + ai * 128 + m * 16;
                        f32x4 v0 = acc[ai][bj][m][0] + gb0, v1 = acc[ai][bj][m][1] + gb1;
#pragma unroll
                        for (int i = 0; i < 4; ++i) { v0[i] = sigmoidf_(v0[i]); v1[i] = sigmoidf_(v1[i]); }
                        *(u32x4*)(G + (size_t)row * 2048 + 128 * bj) = pack8(v0, v1);
                    }
            }
        }
    }
};
template <int PASS> struct EpiBranch {
    static constexpr bool PERM = true, AFTER_DRAIN = false;
    unsigned char* ws;
    DI void operator()(const f32x4 (&acc)[2][2][4][2], const Unit& u, int wr, int wc, int fr, int fq) const {
        const int row0 = u.pm * 256 + wr * 64 + fr, col0 = u.pn * 256 + wc * 32 + 8 * fq;
        const bf16_t* G = (const bf16_t*)(ws + WS_G) + (PASS - 1) * 1024 + col0; bf16_t* T = (bf16_t*)(ws + WS_T) + col0; bf16_t* MG = (bf16_t*)(ws + WS_MERGED) + col0;
#pragma unroll
        for (int ai = 0; ai < 2; ++ai)
#pragma unroll
            for (int m = 0; m < 4; ++m) {
                const int row = row0 + ai * 128 + m * 16;
#pragma unroll
                for (int bj = 0; bj < 2; ++bj) {
                    f32x4 g0, g1; unpack8(*(const u32x4*)(G + (size_t)row * 2048 + 128 * bj), g0, g1);
                    f32x4 r0 = g0 * acc[ai][bj][m][0], r1 = g1 * acc[ai][bj][m][1];
                    if (PASS == 2) { f32x4 t0, t1; unpack8(*(const u32x4*)(T + (size_t)row * 1024 + 128 * bj), t0, t1); r0 = r0 + t0; r1 = r1 + t1; }
                    *(u32x4*)((PASS == 1 ? T : MG) + (size_t)row * 1024 + 128 * bj) = pack8(r0, r1);
                }
            }
    }
};
template <bool WITH_BF> struct EpiRes {
    static constexpr bool PERM = false, AFTER_DRAIN = false;
    const float* base; float* dst; bf16_t* xb; float* RS;
    DI void operator()(const f32x4 (&acc)[2][2][4][2], const Unit& u, int wr, int wc, int fr, int fq) const {
        const int row0 = u.pm * 256 + wr * 64 + fr, col0 = u.pn * 256 + wc * 32 + 4 * fq;
#pragma unroll
        for (int ai = 0; ai < 2; ++ai)
#pragma unroll
            for (int m = 0; m < 4; ++m) {
                const int row = row0 + ai * 128 + m * 16; const size_t off = (size_t)row * 1024 + col0; float ss = 0.f;
#pragma unroll
                for (int bj = 0; bj < 2; ++bj)
#pragma unroll
                    for (int n = 0; n < 2; ++n) {
                        const f32x4 v = *(const f32x4*)(base + off + bj * 128 + n * 16) + acc[ai][bj][m][n];
                        *(f32x4*)(dst + off + bj * 128 + n * 16) = v;
                        if (WITH_BF) { uint2 w; w.x = cvtpk(v[0], v[1]); w.y = cvtpk(v[2], v[3]); *(uint2*)(xb + off + bj * 128 + n * 16) = w; }
                        ss += (v[0] * v[0] + v[1] * v[1]) + (v[2] * v[2] + v[3] * v[3]);
                    }
                ss += __shfl_xor(ss, 16); ss += __shfl_xor(ss, 32);
                if (fq == 0) RS[(size_t)row * 16 + u.pn * 4 + wc] = ss;
            }
    }
};
struct EpiFF1 {
    static constexpr bool PERM = true, AFTER_DRAIN = false;
    unsigned char* ws;
    DI void operator()(const f32x4 (&acc)[2][2][4][2], const Unit& u, int wr, int wc, int fr, int fq) const {
        const int row0 = u.pm * 256 + wr * 64 + fr, hc0 = u.pn * 128 + wc * 32 + 8 * fq;
        bf16_t* HF = (bf16_t*)(ws + WS_HF) + hc0; const float* RS = (const float*)(ws + WS_ROWSS1);
#pragma unroll
        for (int ai = 0; ai < 2; ++ai)
#pragma unroll
            for (int m = 0; m < 4; ++m) {
                const int row = row0 + ai * 128 + m * 16;
                const f32x4* rp = (const f32x4*)(RS + (size_t)row * 16); const f32x4 s4 = (rp[0] + rp[1]) + (rp[2] + rp[3]);
                const float rs = 1.0f / sqrtf(((s4[0] + s4[1]) + (s4[2] + s4[3])) * (1.0f / 1024.0f) + 1e-6f);
                f32x4 h0, h1;
#pragma unroll
                for (int i = 0; i < 4; ++i) {
                    const float g0 = acc[ai][0][m][0][i] * rs, g1 = acc[ai][0][m][1][i] * rs;
                    h0[i] = g0 * sigmoidf_(g0) * (acc[ai][1][m][0][i] * rs); h1[i] = g1 * sigmoidf_(g1) * (acc[ai][1][m][1][i] * rs);
                }
                *(u32x4*)(HF + (size_t)row * DFF) = pack8(h0, h1);
            }
    }
};

namespace cg = cooperative_groups;
constexpr int MK_THREADS = 512, MK_LDS = 159744, MK_MISC_OFF = MK_LDS - 64;
static_assert(IX_LDS <= MK_MISC_OFF && XCD_BAR_WORDS * 4 <= 16384 && attn_body::ATTN_LDS_BYTES <= MK_LDS && pg8::STAGE_BYTES <= MK_LDS, "LDS map");
struct MArgs { const float* in[19]; float* out; unsigned char* ws; int ph_lo, ph_hi, sub, pad; };
enum { PH_PRO = 0, PH_INPROJ = 1, PH_IXDIFF = 2, PH_DSACMB = 3, PH_BRANCH = 4, PH_OUT = 5, PH_FF1 = 6, PH_FF2 = 7, PH_FINAL = 8, PH_END = 9 };

DI void prologue_phase(const MArgs& a, char* ldsc, int vcu, int G, const int wid_s) {
    const int lane = lane_id_asm(), wid = wid_s;
    float* scr = (float*)ldsc + wid * (64 * 33);
    const int gw = vcu * 8 + wid, NGW = G * 8;
    unsigned char* ws = a.ws;
    for (int it = gw; it < IT_ALL; it += NGW) {
        int r = it;
        if (r < IT_IN) { transpose_item<1>(a.in[3], 1024, 5416, a.in[2], (bf16_t*)(ws + WS_WT_IN), r, 176, scr, lane); continue; } r -= IT_IN;
        if (r < IT_FF1) { transpose_item<2>(a.in[16], 1024, 5632, a.in[15], (bf16_t*)(ws + WS_WT_FF1), r, 176, scr, lane); continue; } r -= IT_FF1;
        if (r < IT_FF2) { transpose_item<0>(a.in[17], 2816, 1024, nullptr, (bf16_t*)(ws + WS_WT_FF2), r, 32, scr, lane); continue; } r -= IT_FF2;
        if (r < IT_OUT) { transpose_item<0>(a.in[14], 1024, 1024, nullptr, (bf16_t*)(ws + WS_WT_OUT), r, 32, scr, lane); continue; } r -= IT_OUT;
        if (r < IT_DSA) { transpose_item<0>(a.in[12], 512, 1024, nullptr, (bf16_t*)(ws + WS_WT_DSA), r, 32, scr, lane); continue; } r -= IT_DSA;
        transpose_item<0>(a.in[13], 512, 1024, nullptr, (bf16_t*)(ws + WS_WT_DIFF), r, 32, scr, lane);
    }
    const float* x = a.in[0]; const int* pos = (const int*)a.in[1];
    bf16_t* XN = (bf16_t*)(ws + WS_XN); float2* RH = (float2*)(ws + WS_ROPE_H); float2* RI = (float2*)(ws + WS_ROPE_I);
    for (int m = gw; m < M; m += NGW) {
        const f32x4* xr = (const f32x4*)(x + (size_t)m * D) + lane;
        f32x4 v[4]; float s = 0.f;
#pragma unroll
        for (int j = 0; j < 4; ++j) { v[j] = xr[64 * j]; s += (v[j].x * v[j].x + v[j].y * v[j].y) + (v[j].z * v[j].z + v[j].w * v[j].w); }
        const float rstd = 1.0f / sqrtf(wave_sum(s) * (1.f / D) + 1e-6f);
        u64* o8 = (u64*)(XN + (size_t)m * D) + lane;
#pragma unroll
        for (int j = 0; j < 4; ++j) o8[64 * j] = (u64)cvtpk(v[j].x * rstd, v[j].y * rstd) | ((u64)cvtpk(v[j].z * rstd, v[j].w * rstd) << 32);
        if (lane < 12) {
            const float p = (float)pos[m];
            const bool hd = lane < 8; const int j = hd ? lane : lane - 8;
            const float ex = hd ? -(float)(2 * j) / 16.0f : -(float)(2 * j) / 8.0f;
            const float ang = p * powf(ROPE_THETA, ex);
            float2 cs; cs.x = cosf(ang); cs.y = sinf(ang);
            if (hd) RH[(size_t)m * 8 + j] = cs; else RI[(size_t)m * 4 + j] = cs;
        }
    }
}
DI void combine_phase(const MArgs& a, int vcu, int G, const int wid_s) {
    const int lane = lane_id_asm(), gw = vcu * 8 + wid_s, NGW = G * 8;
    const bf16_t* OB1 = (const bf16_t*)((unsigned char*)a.out + DO_OB1); bf16_t* OBN = (bf16_t*)((unsigned char*)a.out + DO_OBN);
    const float s1 = wave_sum(a.in[6][lane] * a.in[7][lane]), s2 = wave_sum(a.in[8][lane] * a.in[9][lane]);
    const float lam = expf(s1) - expf(s2) + 0.2f;
    const float g0 = a.in[10][2 * lane], g1 = a.in[10][2 * lane + 1];
    for (int m = gw; m < M; m += NGW) {
#pragma unroll
        for (int h = 0; h < 4; ++h) {
            const unsigned aw = *(const unsigned*)(OB1 + (size_t)m * 1024 + (2 * h) * 128 + 2 * lane);
            const unsigned cw = *(const unsigned*)(OB1 + (size_t)m * 1024 + (2 * h + 1) * 128 + 2 * lane);
            const float v0 = __uint_as_float(aw << 16) - lam * __uint_as_float(cw << 16), v1 = __uint_as_float(aw & 0xffff0000u) - lam * __uint_as_float(cw & 0xffff0000u);
            const float ss = wave_sum(v0 * v0 + v1 * v1);
            const float rs = 0.8f / sqrtf(ss * (1.f / 128.f) + 1e-5f);
            *(unsigned*)(OBN + (size_t)m * 512 + h * 128 + 2 * lane) = cvtpk(v0 * rs * g0, v1 * rs * g1);
        }
    }
}
DI void final_phase(const MArgs& a, int vcu, int G, const int wid_s) {
    const int lane = lane_id_asm(), gw = vcu * 8 + wid_s, NGW = G * 8;
    const float* RS = (const float*)(a.ws + WS_ROWSS2); const f32x4* gv = (const f32x4*)a.in[18] + lane;
    for (int m = gw; m < M; m += NGW) {
        const f32x4* rp = (const f32x4*)(RS + (size_t)m * 16); const f32x4 s4 = (rp[0] + rp[1]) + (rp[2] + rp[3]);
        const float rs = 1.0f / sqrtf(((s4[0] + s4[1]) + (s4[2] + s4[3])) * (1.0f / 1024.0f) + 1e-6f);
        const f32x4* xi = (const f32x4*)((const float*)(a.ws + WS_X2) + (size_t)m * D) + lane; f32x4* o = (f32x4*)(a.out + (size_t)m * D) + lane;
#pragma unroll
        for (int j = 0; j < 4; ++j) { f32x4 v = xi[64 * j]; v = v * rs * gv[64 * j]; o[64 * j] = v; }
    }
}

__global__ void __launch_bounds__(MK_THREADS, 2) mk_fwd(MArgs a) {
    extern __shared__ __attribute__((aligned(16))) unsigned char lds_raw[];
    PG8_LAS unsigned char* lds = (PG8_LAS unsigned char*)lds_raw;
    unsigned char* ws = a.ws; unsigned char* dob = (unsigned char*)a.out;
    const int G = gridDim.x, bx = blockIdx.x;
    const int wid_s = __builtin_amdgcn_readfirstlane(threadIdx.x >> 6);
    const int vcu = (G % 8 == 0) ? (bx % 8) * (G / 8) + bx / 8 : bx;
#define IN(k) (a.ph_lo <= (k) && (k) < a.ph_hi)
#define SEAM(k) do { if (IN(k) && IN((k) + 1)) xcd_barrier(xbar, leader); } while (0)
    volatile LAS unsigned* misc = (volatile LAS unsigned*)(lds + MK_MISC_OFF);
    if (threadIdx.x < 2) misc[threadIdx.x] = 0u;
    cg::this_grid().sync();
    const bool leader = (wid_s == 0) && (lane_id_asm() == 0);
    const XcdBarrier xbar = xcd_barrier_post((unsigned*)(ws + WS_CTL), misc, leader);
    if (IN(PH_PRO)) prologue_phase(a, (char*)lds_raw, vcu, G, wid_s);
    SEAM(PH_PRO);
    if (IN(PH_INPROJ)) {
        pg8::Gemm g{(const bf16_t*)(ws + WS_XN), (const bf16_t*)(ws + WS_WT_IN), M, NPROJ, 1024}; pg8::StaticOrder So; So.init(M, NPROJ, G, bx);
        EpiIn E{ws, a.in[4], a.in[5], a.in[11]};
        pg8::gemm_phase<EpiIn, pg8::StaticOrder, true, true>(lds, g, So, E, wid_s);
    }
    SEAM(PH_INPROJ);
    if (IN(PH_IXDIFF)) {
        if (a.sub & 1) index_phase(ws, (char*)lds_raw, G, bx, wid_s, a.sub);
        typedef attn_body::bf16 abf;
        for (int L = vcu; L < 256 && (a.sub & 2); L += G) {
            for (int i = 0; i < 4; ++i) {
                int Lo = L; asm volatile("" : "+s"(Lo));
                const int bh = Lo >> 3, s = Lo & 7, b = bh >> 4, p = bh & 15, hm = p >> 1, vh = p & 1, h = hm >> 1;
                const int qb = (i == 0) ? s : (i == 1) ? 15 - s : (i == 2) ? 16 + s : 31 - s;
                attn_body::attn_unit<8, 512, 512, 512, 1024, false>(b, qb, (const abf*)(ws + WS_QB) + hm * 64, (const abf*)(ws + WS_KB) + hm * 64, (const abf*)(ws + WS_VB) + h * 128 + vh * 64,
                                                                (abf*)(dob + DO_OB1) + hm * 128 + vh * 64, nullptr, (char*)lds_raw, wid_s);
            }
        }
    }
    SEAM(PH_IXDIFF);
    if (IN(PH_DSACMB)) {
        typedef attn_body::bf16 abf;
        for (int L = vcu; L < 256; L += G) {
            for (int i = 0; i < 2; ++i) {
                int Lo = L; asm volatile("" : "+s"(Lo));
                const int bh = Lo >> 4, s = Lo & 15, b = bh >> 3, h = bh & 7;
                const int qb = (i == 0) ? s : 31 - s;
                attn_body::attn_unit<8, 512, 512, 512, 512, true>(b, qb, (const abf*)(ws + WS_QA) + h * 64, (const abf*)(ws + WS_KA) + h * 64, (const abf*)(ws + WS_VA) + h * 64,
                                                              (abf*)(dob + DO_OA) + h * 64, (const u64*)(ws + WS_MASK), (char*)lds_raw, wid_s);
            }
        }
        combine_phase(a, vcu, G, wid_s);
    }
    SEAM(PH_DSACMB);
    if (IN(PH_BRANCH)) {
        { pg8::Gemm g{(const bf16_t*)(dob + DO_OA), (const bf16_t*)(ws + WS_WT_DSA), M, 1024, 512}; pg8::StaticOrder So; So.init(M, 1024, G, bx);
          EpiBranch<1> E{ws}; pg8::gemm_phase<EpiBranch<1>, pg8::StaticOrder, true, true>(lds, g, So, E, wid_s); }
        { pg8::Gemm g{(const bf16_t*)(dob + DO_OBN), (const bf16_t*)(ws + WS_WT_DIFF), M, 1024, 512}; pg8::StaticOrder So; So.init(M, 1024, G, bx);
          EpiBranch<2> E{ws}; pg8::gemm_phase<EpiBranch<2>, pg8::StaticOrder, true, true>(lds, g, So, E, wid_s); }
    }
    SEAM(PH_BRANCH);
    if (IN(PH_OUT)) {
        pg8::Gemm g{(const bf16_t*)(ws + WS_MERGED), (const bf16_t*)(ws + WS_WT_OUT), M, 1024, 1024}; pg8::StaticOrder So; So.init(M, 1024, G, bx);
        EpiRes<true> E{a.in[0], a.out, (bf16_t*)(ws + WS_X1B), (float*)(ws + WS_ROWSS1)};
        pg8::gemm_phase<EpiRes<true>, pg8::StaticOrder, true, true>(lds, g, So, E, wid_s);
    }
    SEAM(PH_OUT);
    if (IN(PH_FF1)) {
        pg8::Gemm g{(const bf16_t*)(ws + WS_X1B), (const bf16_t*)(ws + WS_WT_FF1), M, NFF1, 1024}; pg8::StaticOrder So; So.init(M, NFF1, G, bx);
        EpiFF1 E{ws}; pg8::gemm_phase<EpiFF1, pg8::StaticOrder, true, true>(lds, g, So, E, wid_s);
    }
    SEAM(PH_FF1);
    if (IN(PH_FF2)) {
        pg8::Gemm g{(const bf16_t*)(ws + WS_HF), (const bf16_t*)(ws + WS_WT_FF2), M, 1024, DFF}; pg8::StaticOrder So; So.init(M, 1024, G, bx);
        EpiRes<false> E{a.out, (float*)(ws + WS_X2), nullptr, (float*)(ws + WS_ROWSS2)};
        pg8::gemm_phase<EpiRes<false>, pg8::StaticOrder, true, true>(lds, g, So, E, wid_s);
    }
    SEAM(PH_FF2);
    if (IN(PH_FINAL)) final_phase(a, vcu, G, wid_s);
#undef IN
#undef SEAM
}

extern "C" void kernel_launch(void* const* d_in, const int* in_sizes, int n_in, void* d_out, int out_size, void* d_ws, size_t ws_size, hipStream_t stream) {
    if (n_in != 19 || out_size != M * D || ws_size < WS_END) { fprintf(stderr, "kernel_launch: unexpected shapes (n_in %d out %d ws %zu)\n", n_in, out_size, ws_size); return; }
    static int grid = 0;
    if (!grid) {
        if (hipFuncSetAttribute((const void*)mk_fwd, hipFuncAttributeMaxDynamicSharedMemorySize, MK_LDS) != hipSuccess) fprintf(stderr, "kernel_launch: hipFuncSetAttribute failed\n");
        int dev = 0, cus = 0, per_cu = 0;
        hipGetDevice(&dev); hipDeviceGetAttribute(&cus, hipDeviceAttributeMultiprocessorCount, dev);
        if (hipOccupancyMaxActiveBlocksPerMultiprocessor(&per_cu, (const void*)mk_fwd, MK_THREADS, MK_LDS) != hipSuccess || per_cu < 1) { fprintf(stderr, "kernel_launch: occupancy query gave %d\n", per_cu); per_cu = 1; }
        grid = cus * per_cu;
        (void)hipGetLastError();
    }
    if (hipMemsetAsync((char*)d_ws + WS_CTL, 0, 16384, stream) != hipSuccess) { fprintf(stderr, "kernel_launch: memset of the barrier words failed\n"); return; }
    MArgs ma{};
    for (int i = 0; i < 19; ++i) ma.in[i] = (const float*)d_in[i];
    ma.out = (float*)d_out; ma.ws = (unsigned char*)d_ws; ma.ph_lo = 0; ma.ph_hi = PH_END; ma.sub = 3;
    void* args[] = {&ma};
    const hipError_t e = hipLaunchCooperativeKernel((const void*)mk_fwd, dim3(grid), dim3(MK_THREADS), args, MK_LDS, stream);
    if (e != hipSuccess) fprintf(stderr, "kernel_launch: cooperative launch failed: %s (grid %d)\n", hipGetErrorString(e), grid);
}
```

```cpp
#include <hip/hip_runtime.h>
#include <hip/hip_cooperative_groups.h>
#include <cstdint>
#include <cstdio>

#define DI __device__ __forceinline__
typedef unsigned short bf16_t;
typedef short bf16x8 __attribute__((ext_vector_type(8)));
typedef float f32x16 __attribute__((ext_vector_type(16)));
typedef float f32x4 __attribute__((ext_vector_type(4)));
typedef unsigned u32x4 __attribute__((ext_vector_type(4)));
typedef unsigned long long u64;

constexpr int NB = 2, S = 8192, D = 1024, M = NB * S;
constexpr int NPROJ = 5632, DFF = 2816, NFF1 = 5632;
constexpr float C2 = 0.125f * 1.4426950408889634f;
constexpr float ROPE_THETA = 500000.0f;

constexpr size_t MiB = 1u << 20;
constexpr size_t WS_CTL = 0;
constexpr size_t WS_WT_IN = 1 * MiB, WS_WT_FF1 = 12 * MiB, WS_WT_FF2 = 23 * MiB, WS_WT_OUT = 29 * MiB, WS_WT_DSA = 31 * MiB, WS_WT_DIFF = 32 * MiB;
constexpr size_t WS_ROPE_H = 33 * MiB, WS_ROPE_I = 34 * MiB, WS_ROWSS1 = 34 * MiB + 512 * 1024;
constexpr size_t WS_XN = 36 * MiB, WS_MASK = 36 * MiB, WS_T = 36 * MiB;
constexpr size_t WS_QA = 68 * MiB, WS_KA = 84 * MiB, WS_VA = 100 * MiB, WS_QB = 116 * MiB, WS_KB = 132 * MiB, WS_VB = 148 * MiB;
constexpr size_t WS_QI = 164 * MiB, WS_KI = 172 * MiB, WS_WI = 173 * MiB;
constexpr size_t WS_G = 174 * MiB, WS_ROWSS2 = 238 * MiB;
constexpr size_t WS_MERGED = 84 * MiB, WS_X1B = 116 * MiB, WS_HF = 148 * MiB;
constexpr size_t WS_END = 256 * MiB;
constexpr size_t DO_OB1 = 0, DO_OBN = 32 * MiB, DO_OA = 48 * MiB;
constexpr size_t WS_X2 = 36 * MiB;

DI int lane_id_asm() { int l; asm volatile("v_mbcnt_lo_u32_b32 %0, -1, 0\n\tv_mbcnt_hi_u32_b32 %0, -1, %0" : "=v"(l)); return l; }
DI float bf2f(bf16_t v) { return __uint_as_float((unsigned)v << 16); }
DI bf16_t f2bf(float f) { unsigned u = __float_as_uint(f); return (bf16_t)((u + 0x7fffu + ((u >> 16) & 1u)) >> 16); }
DI unsigned pk2(float lo, float hi) { return (unsigned)f2bf(lo) | ((unsigned)f2bf(hi) << 16); }
DI int crow(int r, int hi) { return (r & 3) + 8 * (r >> 2) + 4 * hi; }
DI float wave_sum(float v) {
#pragma unroll
    for (int o = 1; o < 64; o <<= 1) v += __shfl_xor(v, o);
    return v;
}
DI float wave_max(float v) {
#pragma unroll
    for (int o = 1; o < 64; o <<= 1) v = fmaxf(v, __shfl_xor(v, o));
    return v;
}
DI unsigned wave_sum_u(unsigned v) {
#pragma unroll
    for (int o = 1; o < 64; o <<= 1) v += __shfl_xor(v, o);
    return v;
}

DI int map_in(int v) {
    if (v < 1536) return v;
    if (v < 3072) return 1832 + (v - 1536);
    if (v < 3328) return 1536 + (v - 3072);
    if (v < 3360) return 1792 + (v - 3328);
    if (v < 3368) return 1824 + (v - 3360);
    if (v < 3584) return -1;
    return 3368 + (v - 3584);
}
DI int map_ff1(int v) { const int pn = v >> 8, o = v & 255; return (o < 128) ? (128 * pn + o) : (DFF + 128 * pn + (o - 128)); }

template <int MAPK> DI void transpose_item(const float* W, int K, int Nsrc, const float* gain, bf16_t* WT, int item, int nblk, float* scr, int lane) {
    const int kb = item / nblk, nb = item % nblk, k0 = 64 * kb, n0 = 32 * nb;
    const int v = n0 + (lane & 31);
    const int src = MAPK == 1 ? map_in(v) : (MAPK == 2 ? map_ff1(v) : v);
#pragma unroll 8
    for (int i = 0; i < 32; ++i) {
        const int kk = 2 * i + (lane >> 5);
        float x = (src >= 0) ? W[(size_t)(k0 + kk) * Nsrc + src] : 0.f;
        if (gain) x *= gain[k0 + kk];
        scr[kk * 33 + (lane & 31)] = x;
    }
    asm volatile("s_waitcnt lgkmcnt(0)" ::: "memory");
    const int c = lane & 7;
#pragma unroll
    for (int j = 0; j < 4; ++j) {
        const int n = (lane >> 3) + 8 * j; const float* s = scr + (8 * c) * 33 + n;
        u32x4 o; o.x = pk2(s[0 * 33], s[1 * 33]); o.y = pk2(s[2 * 33], s[3 * 33]); o.z = pk2(s[4 * 33], s[5 * 33]); o.w = pk2(s[6 * 33], s[7 * 33]);
        *(u32x4*)(WT + (size_t)(n0 + n) * K + k0 + 8 * c) = o;
    }
    asm volatile("s_waitcnt lgkmcnt(0)" ::: "memory");
}

struct PArgs {
    const float* in[19]; float* out; unsigned char* ws;
};

constexpr int IT_IN = 16 * 176, IT_FF1 = 16 * 176, IT_FF2 = 44 * 32, IT_OUT = 16 * 32, IT_DSA = 8 * 32, IT_DIFF = 8 * 32;
constexpr int IT_ALL = IT_IN + IT_FF1 + IT_FF2 + IT_OUT + IT_DSA + IT_DIFF;

__global__ void __launch_bounds__(64) nk_prologue(PArgs a) {
    __shared__ float scr[64 * 33];
    const int lane = threadIdx.x;
    const int gw = blockIdx.x, NGW = gridDim.x;
    unsigned char* ws = a.ws;
    for (int it = gw; it < IT_ALL; it += NGW) {
        int r = it;
        if (r < IT_IN) { transpose_item<1>(a.in[3], 1024, 5416, a.in[2], (bf16_t*)(ws + WS_WT_IN), r, 176, scr, lane); continue; } r -= IT_IN;
        if (r < IT_FF1) { transpose_item<2>(a.in[16], 1024, 5632, a.in[15], (bf16_t*)(ws + WS_WT_FF1), r, 176, scr, lane); continue; } r -= IT_FF1;
        if (r < IT_FF2) { transpose_item<0>(a.in[17], 2816, 1024, nullptr, (bf16_t*)(ws + WS_WT_FF2), r, 32, scr, lane); continue; } r -= IT_FF2;
        if (r < IT_OUT) { transpose_item<0>(a.in[14], 1024, 1024, nullptr, (bf16_t*)(ws + WS_WT_OUT), r, 32, scr, lane); continue; } r -= IT_OUT;
        if (r < IT_DSA) { transpose_item<0>(a.in[12], 512, 1024, nullptr, (bf16_t*)(ws + WS_WT_DSA), r, 32, scr, lane); continue; } r -= IT_DSA;
        transpose_item<0>(a.in[13], 512, 1024, nullptr, (bf16_t*)(ws + WS_WT_DIFF), r, 32, scr, lane);
    }
    const float* x = a.in[0]; const int* pos = (const int*)a.in[1];
    bf16_t* XN = (bf16_t*)(ws + WS_XN); float2* RH = (float2*)(ws + WS_ROPE_H); float2* RI = (float2*)(ws + WS_ROPE_I);
    for (int m = gw; m < M; m += NGW) {
        const f32x4* xr = (const f32x4*)(x + (size_t)m * D) + lane;
        f32x4 v[4]; float s = 0.f;
#pragma unroll
        for (int j = 0; j < 4; ++j) { v[j] = xr[64 * j]; s += (v[j].x * v[j].x + v[j].y * v[j].y) + (v[j].z * v[j].z + v[j].w * v[j].w); }
        const float rstd = 1.0f / sqrtf(wave_sum(s) * (1.f / D) + 1e-6f);
        u64* o8 = (u64*)(XN + (size_t)m * D) + lane;
#pragma unroll
        for (int j = 0; j < 4; ++j) o8[64 * j] = (u64)pk2(v[j].x * rstd, v[j].y * rstd) | ((u64)pk2(v[j].z * rstd, v[j].w * rstd) << 32);
        if (lane < 12) {
            const float p = (float)pos[m];
            const bool hd = lane < 8; const int j = hd ? lane : lane - 8;
            const float ex = hd ? -(float)(2 * j) / 16.0f : -(float)(2 * j) / 8.0f;
            const float inv = powf(ROPE_THETA, ex);
            const float ang = p * inv;
            float2 cs; cs.x = cosf(ang); cs.y = sinf(ang);
            if (hd) RH[(size_t)m * 8 + j] = cs; else RI[(size_t)m * 4 + j] = cs;
        }
    }
}

#define MFMA32(a, b, c) __builtin_amdgcn_mfma_f32_32x32x16_bf16((a), (b), (c), 0, 0, 0)
template <class Epi, bool DUAL>
__global__ void __launch_bounds__(256) ngemm_k(const bf16_t* A, int lda, const bf16_t* Bt, int ldb, int K, int ntn, Epi epi) {
    __shared__ float Cs[128][65];
    __shared__ float Cs2[DUAL ? 128 : 1][65];
    const int tile = blockIdx.x, tn = tile % ntn, tm = tile / ntn;
    const int tid = threadIdx.x, wid = tid >> 6, lane = tid & 63, r = lane & 31, h = lane >> 5;
    const int n0 = DUAL ? ((tn >> 1) * 256 + (tn & 1) * 64) : tn * 64;
    const int m0 = tm * 128 + wid * 32;
    f32x16 acc0 = {}, acc1 = {}, acc2 = {}, acc3 = {};
    const bf16_t* ap = A + (size_t)(m0 + r) * lda + 8 * h;
    const bf16_t* bp0 = Bt + (size_t)(n0 + r) * ldb + 8 * h;
    const bf16_t* bp1 = bp0 + (size_t)32 * ldb;
    const bf16_t* bp2 = bp0 + (size_t)128 * ldb;
    const bf16_t* bp3 = bp0 + (size_t)160 * ldb;
    for (int k = 0; k < K; k += 16) {
        const bf16x8 av = *(const bf16x8*)(ap + k), b0 = *(const bf16x8*)(bp0 + k), b1 = *(const bf16x8*)(bp1 + k);
        acc0 = MFMA32(av, b0, acc0); acc1 = MFMA32(av, b1, acc1);
        if (DUAL) { const bf16x8 b2 = *(const bf16x8*)(bp2 + k), b3 = *(const bf16x8*)(bp3 + k); acc2 = MFMA32(av, b2, acc2); acc3 = MFMA32(av, b3, acc3); }
    }
#pragma unroll
    for (int i = 0; i < 16; ++i) {
        const int rr = wid * 32 + crow(i, h);
        Cs[rr][r] = acc0[i]; Cs[rr][32 + r] = acc1[i];
        if (DUAL) { Cs2[rr][r] = acc2[i]; Cs2[rr][32 + r] = acc3[i]; }
    }
    __syncthreads();
    epi(tm * 128, n0, Cs, Cs2, tid);
}

struct NEpiIn {
    unsigned char* ws; const float* ki_g; const float* ki_b; const float* gate_b;
    DI void operator()(int m0, int n0, float (*Cs)[65], float (*)[65], int tid) const {
        const float2* RH = (const float2*)(ws + WS_ROPE_H); const float2* RI = (const float2*)(ws + WS_ROPE_I);
        if (n0 < 3072) {
            const int seg = n0 / 512, cb = n0 % 512;
            bf16_t* O = (bf16_t*)(ws + WS_QA + (size_t)seg * 16 * MiB);
            const bool rope = (seg % 3) != 2, isq = (seg % 3) == 0;
            for (int e = tid; e < 128 * 64; e += 256) {
                const int row = e >> 6, c = e & 63; float v = Cs[row][c];
                if (rope && c < 16) { const float2 cs = RH[(size_t)(m0 + row) * 8 + (c & 7)];
                    v = (c < 8) ? (v * cs.x - Cs[row][c + 8] * cs.y) : (v * cs.x + Cs[row][c - 8] * cs.y); }
                if (isq) v *= C2;
                O[(size_t)(m0 + row) * 512 + cb + c] = f2bf(v);
            }
        } else if (n0 < 3328) {
            bf16_t* O = (bf16_t*)(ws + WS_QI);
            for (int e = tid; e < 128 * 64; e += 256) {
                const int row = e >> 6, c = e & 63, c32 = c & 31; float v = Cs[row][c];
                if (c32 < 8) { const float2 cs = RI[(size_t)(m0 + row) * 4 + (c32 & 3)];
                    v = (c32 < 4) ? (v * cs.x - Cs[row][c + 4] * cs.y) : (v * cs.x + Cs[row][c - 4] * cs.y); }
                O[(size_t)(m0 + row) * 256 + (n0 - 3072) + c] = f2bf(v);
            }
        } else if (n0 == 3328) {
            bf16_t* KI = (bf16_t*)(ws + WS_KI); float* WI = (float*)(ws + WS_WI);
            for (int e = tid; e < 128 * 40; e += 256) {
                const int row = e / 40, c = e % 40;
                if (c < 32) {
                    float mu = 0.f; for (int j = 0; j < 32; ++j) mu += Cs[row][j]; mu *= (1.f / 32.f);
                    float var = 0.f; for (int j = 0; j < 32; ++j) { const float d = Cs[row][j] - mu; var += d * d; } var *= (1.f / 32.f);
                    const float rs = 1.0f / sqrtf(var + 1e-6f);
                    float v = (Cs[row][c] - mu) * rs * ki_g[c] + ki_b[c];
                    if (c < 8) { const int cp = (c < 4) ? c + 4 : c - 4; const float vp = (Cs[row][cp] - mu) * rs * ki_g[cp] + ki_b[cp];
                        const float2 cs = RI[(size_t)(m0 + row) * 4 + (c & 3)];
                        v = (c < 4) ? (v * cs.x - vp * cs.y) : (v * cs.x + vp * cs.y); }
                    KI[(size_t)(m0 + row) * 32 + c] = f2bf(v);
                } else WI[(size_t)(m0 + row) * 8 + (c - 32)] = Cs[row][c] * (1.0f / 16.0f);
            }
        } else if (n0 >= 3584) {
            bf16_t* G = (bf16_t*)(ws + WS_G);
            for (int e = tid; e < 128 * 64; e += 256) {
                const int row = e >> 6, c = e & 63, cg = n0 - 3584 + c;
                const float v = Cs[row][c] + gate_b[cg];
                G[(size_t)(m0 + row) * 2048 + cg] = f2bf(1.0f / (1.0f + __expf(-v)));
            }
        }
    }
};
template <int PASS> struct NEpiBranch {
    unsigned char* ws;
    DI void operator()(int m0, int n0, float (*Cs)[65], float (*)[65], int tid) const {
        const bf16_t* G = (const bf16_t*)(ws + WS_G); bf16_t* T = (bf16_t*)(ws + WS_T); bf16_t* MG = (bf16_t*)(ws + WS_MERGED);
        for (int e = tid; e < 128 * 64; e += 256) {
            const int row = e >> 6, c = e & 63; const size_t o = (size_t)(m0 + row) * 1024 + n0 + c;
            const float g = bf2f(G[(size_t)(m0 + row) * 2048 + (PASS - 1) * 1024 + n0 + c]);
            if (PASS == 1) T[o] = f2bf(g * Cs[row][c]); else MG[o] = f2bf(bf2f(T[o]) + g * Cs[row][c]);
        }
    }
};
struct NEpiOut {
    unsigned char* ws; const float* x; float* out;
    DI void operator()(int m0, int n0, float (*Cs)[65], float (*)[65], int tid) const {
        bf16_t* X1B = (bf16_t*)(ws + WS_X1B); float* RS = (float*)(ws + WS_ROWSS1);
        for (int e = tid; e < 128 * 64; e += 256) {
            const int row = e >> 6, c = e & 63; const size_t o = (size_t)(m0 + row) * 1024 + n0 + c;
            const float v = x[o] + Cs[row][c]; out[o] = v; X1B[o] = f2bf(v); Cs[row][c] = v;
        }
        __syncthreads();
        if (tid < 128) { float s = 0.f; for (int c = 0; c < 64; ++c) s += Cs[tid][c] * Cs[tid][c]; RS[(size_t)(m0 + tid) * 16 + (n0 >> 6)] = s; }
    }
};
DI float row_rstd(const float* RS, int row) { float s = 0.f; for (int i = 0; i < 16; ++i) s += RS[(size_t)row * 16 + i]; return 1.0f / sqrtf(s * (1.f / 1024.f) + 1e-6f); }
struct NEpiFF1 {
    unsigned char* ws;
    DI void operator()(int m0, int n0, float (*Cs)[65], float (*Cs2)[65], int tid) const {
        bf16_t* HF = (bf16_t*)(ws + WS_HF); const float* RS = (const float*)(ws + WS_ROWSS1);
        const int hc = (n0 >> 8) * 128 + (n0 & 255);
        for (int e = tid; e < 128 * 64; e += 256) {
            const int row = e >> 6, c = e & 63; const float rs = row_rstd(RS, m0 + row);
            const float g = Cs[row][c] * rs, u = Cs2[row][c] * rs;
            HF[(size_t)(m0 + row) * DFF + hc + c] = f2bf(g / (1.0f + __expf(-g)) * u);
        }
    }
};
struct NEpiFF2 {
    unsigned char* ws; float* out;
    DI void operator()(int m0, int n0, float (*Cs)[65], float (*)[65], int tid) const {
        float* RS = (float*)(ws + WS_ROWSS2);
        for (int e = tid; e < 128 * 64; e += 256) {
            const int row = e >> 6, c = e & 63; const size_t o = (size_t)(m0 + row) * 1024 + n0 + c;
            const float v = out[o] + Cs[row][c]; out[o] = v; Cs[row][c] = v;
        }
        __syncthreads();
        if (tid < 128) { float s = 0.f; for (int c = 0; c < 64; ++c) s += Cs[tid][c] * Cs[tid][c]; RS[(size_t)(m0 + tid) * 16 + (n0 >> 6)] = s; }
    }
};
__global__ void __launch_bounds__(256) nk_final(float* out, const float* RS, const float* g) {
    const int lane = threadIdx.x & 63, gw = blockIdx.x * 4 + (threadIdx.x >> 6), NGW = gridDim.x * 4;
    for (int m = gw; m < M; m += NGW) {
        const float rs = row_rstd(RS, m);
        f32x4* o = (f32x4*)(out + (size_t)m * D) + lane; const f32x4* gv = (const f32x4*)g + lane;
#pragma unroll
        for (int j = 0; j < 4; ++j) { f32x4 v = o[64 * j]; const f32x4 gg = gv[64 * j]; v = v * rs * gg; o[64 * j] = v; }
    }
}

DI unsigned fkey(float f) { const unsigned u = __float_as_uint(f); return (u & 0x80000000u) ? ~u : (u | 0x80000000u); }
__global__ void __launch_bounds__(256) nk_index(const bf16_t* QI, const bf16_t* KI, const float* WI, u64* MASK) {
    __shared__ unsigned su[8192];
    __shared__ unsigned short slist[8192];
    __shared__ float sq[256]; __shared__ float sw[8];
    __shared__ unsigned scnt, scnt2;
    const int tid = threadIdx.x, lane = tid & 63, wid = tid >> 6;
    for (int row = blockIdx.x; row < M; row += gridDim.x) {
        const int b = row / S, t = row % S, n = t + 1;
        sq[tid] = bf2f(QI[(size_t)row * 256 + tid]); if (tid < 8) sw[tid] = WI[(size_t)row * 8 + tid];
        __syncthreads();
        if (n <= 256) {
            if (tid < 128) { const int lo = 64 * tid; MASK[(size_t)row * 128 + tid] = (n - lo >= 64) ? ~0ull : (n > lo ? ((1ull << (n - lo)) - 1ull) : 0ull); }
            __syncthreads();
            continue;
        }
        for (int key = tid; key < n; key += 256) {
            const bf16x8* kp = (const bf16x8*)(KI + ((size_t)b * S + key) * 32);
            float kf[32];
#pragma unroll
            for (int c = 0; c < 4; ++c) { const bf16x8 v = kp[c];
#pragma unroll
                for (int j = 0; j < 8; ++j) kf[c * 8 + j] = bf2f((bf16_t)v[j]); }
            float sc = 0.f;
#pragma unroll
            for (int h = 0; h < 8; ++h) { float d = 0.f;
#pragma unroll
                for (int j = 0; j < 32; ++j) d += sq[h * 32 + j] * kf[j];
                sc += sw[h] * fmaxf(d, 0.f); }
            su[key] = fkey(sc);
        }
        __syncthreads();
        unsigned T = 0;
        for (int bit = 31; bit >= 0; --bit) {
            const unsigned cand = T | (1u << bit);
            if (tid == 0) scnt = 0;
            __syncthreads();
            unsigned c = 0; for (int key = tid; key < n; key += 256) c += (su[key] >= cand) ? 1u : 0u;
            c = wave_sum_u(c); if (lane == 0) atomicAdd(&scnt, c);
            __syncthreads();
            if (scnt >= 256u) T = cand;
            __syncthreads();
        }
        if (tid == 0) { scnt = 0; scnt2 = 0; }
        __syncthreads();
        { unsigned c = 0;
          for (int key = tid; key < n; key += 256) { const unsigned u = su[key]; if (u > T) ++c; else if (u == T) { const unsigned p = atomicAdd(&scnt2, 1u); slist[p] = (unsigned short)key; } }
          c = wave_sum_u(c); if (lane == 0) atomicAdd(&scnt, c); }
        __syncthreads();
        const int need = 256 - (int)scnt, mt = (int)scnt2;
        for (int i = tid; i < mt; i += 256) { const int idx = slist[i]; int rank = 0; for (int j = 0; j < mt; ++j) rank += (slist[j] < idx) ? 1 : 0; if (rank < need) su[idx] = 0xFFFFFFFFu; }
        __syncthreads();
        for (int c = wid; c < 128; c += 4) { const int key = 64 * c + lane; const bool sel = key < n && su[key] > T; const u64 bal = __ballot(sel); if (lane == 0) MASK[(size_t)row * 128 + c] = bal; }
        __syncthreads();
    }
}

__global__ void __launch_bounds__(64) nk_dsa(bf16_t* QAO, const bf16_t* KA, const bf16_t* VA, const u64* MASK) {
    __shared__ unsigned short slist[576]; __shared__ float sp[576]; __shared__ float sqh[64];
    const int lane = threadIdx.x;
    for (int row = blockIdx.x; row < M; row += gridDim.x) {
        const int b = row / S;
        u64 w0 = MASK[(size_t)row * 128 + lane], w1 = MASK[(size_t)row * 128 + 64 + lane];
        const int c0 = __popcll(w0), c1 = __popcll(w1);
        int i0 = c0, i1 = c1;
#pragma unroll
        for (int o = 1; o < 64; o <<= 1) { const int a0 = __shfl_up(i0, o), a1 = __shfl_up(i1, o); if (lane >= o) { i0 += a0; i1 += a1; } }
        const int tot0 = __shfl(i0, 63), tot1 = __shfl(i1, 63);
        int off0 = i0 - c0, off1 = tot0 + i1 - c1;
        int cnt = tot0 + tot1; if (cnt > 512) cnt = 512;
        while (w0) { const int bit = __ffsll((long long)w0) - 1; if (off0 < 512) slist[off0] = (unsigned short)(64 * lane + bit); ++off0; w0 &= w0 - 1; }
        while (w1) { const int bit = __ffsll((long long)w1) - 1; if (off1 < 512) slist[off1] = (unsigned short)(64 * (64 + lane) + bit); ++off1; w1 &= w1 - 1; }
        __syncthreads();
        for (int h = 0; h < 8; ++h) {
            sqh[lane] = bf2f(QAO[(size_t)row * 512 + h * 64 + lane]);
            __syncthreads();
            float mx = -INFINITY;
            for (int i = lane; i < cnt; i += 64) {
                const int key = slist[i]; const bf16x8* kp = (const bf16x8*)(KA + ((size_t)b * S + key) * 512 + h * 64);
                float s = 0.f;
#pragma unroll
                for (int c = 0; c < 8; ++c) { const bf16x8 v = kp[c];
#pragma unroll
                    for (int j = 0; j < 8; ++j) s += sqh[c * 8 + j] * bf2f((bf16_t)v[j]); }
                sp[i] = s; mx = fmaxf(mx, s);
            }
            mx = wave_max(mx);
            float l = 0.f;
            for (int i = lane; i < cnt; i += 64) { const float p = exp2f(sp[i] - mx); sp[i] = p; l += p; }
            l = wave_sum(l);
            __syncthreads();
            float o = 0.f;
            for (int i = 0; i < cnt; ++i) { const int key = slist[i]; o += sp[i] * bf2f(VA[((size_t)b * S + key) * 512 + h * 64 + lane]); }
            o /= l;
            __syncthreads();
            QAO[(size_t)row * 512 + h * 64 + lane] = f2bf(o);
        }
        __syncthreads();
    }
}

__global__ void __launch_bounds__(256) nk_diff(const bf16_t* QB, const bf16_t* KB, const bf16_t* VB, bf16_t* OB1) {
    __shared__ float Ks[32][64]; __shared__ float Vs[32][128];
    const int blk = blockIdx.x, qb = 63 - (blk & 63), hm = (blk >> 6) & 7, b = blk >> 9, h = hm >> 1;
    const int tid = threadIdx.x, qr = tid & 127, vh = tid >> 7;
    const int t = qb * 128 + qr; const size_t row = (size_t)b * S + t;
    float q[64], o[64];
    { const bf16x8* qp = (const bf16x8*)(QB + row * 512 + hm * 64);
#pragma unroll
      for (int c = 0; c < 8; ++c) { const bf16x8 v = qp[c];
#pragma unroll
          for (int j = 0; j < 8; ++j) q[c * 8 + j] = bf2f((bf16_t)v[j]); } }
#pragma unroll
    for (int d = 0; d < 64; ++d) o[d] = 0.f;
    float m = -INFINITY, l = 0.f;
    const int ntile = (qb * 128 + 128) / 32;
    for (int kt = 0; kt < ntile; ++kt) {
        __syncthreads();
        { const size_t kr = (size_t)b * S + kt * 32 + (tid >> 3);
          const bf16x8 v = *(const bf16x8*)(KB + kr * 512 + hm * 64 + (tid & 7) * 8);
#pragma unroll
          for (int j = 0; j < 8; ++j) Ks[tid >> 3][(tid & 7) * 8 + j] = bf2f((bf16_t)v[j]);
          const bf16x8* vp = (const bf16x8*)(VB + kr * 512 + h * 128 + (tid & 7) * 16);
          const bf16x8 v0 = vp[0], v1 = vp[1];
#pragma unroll
          for (int j = 0; j < 8; ++j) { Vs[tid >> 3][(tid & 7) * 16 + j] = bf2f((bf16_t)v0[j]); Vs[tid >> 3][(tid & 7) * 16 + 8 + j] = bf2f((bf16_t)v1[j]); } }
        __syncthreads();
        float s[32]; float tm = -INFINITY;
#pragma unroll
        for (int j = 0; j < 32; ++j) {
            float a = 0.f;
#pragma unroll
            for (int d = 0; d < 64; ++d) a += q[d] * Ks[j][d];
            if (kt * 32 + j > t) a = -INFINITY;
            s[j] = a; tm = fmaxf(tm, a);
        }
        const float mn = fmaxf(m, tm);
        const float sc = exp2f(m - mn);
        l *= sc;
#pragma unroll
        for (int d = 0; d < 64; ++d) o[d] *= sc;
        m = mn;
#pragma unroll
        for (int j = 0; j < 32; ++j) {
            const float p = exp2f(s[j] - m); l += p;
#pragma unroll
            for (int d = 0; d < 64; ++d) o[d] += p * Vs[j][vh * 64 + d];
        }
    }
    const float inv = 1.0f / l;
    bf16_t* op = OB1 + row * 1024 + hm * 128 + vh * 64;
#pragma unroll
    for (int d = 0; d < 64; ++d) op[d] = f2bf(o[d] * inv);
}
__global__ void __launch_bounds__(256) nk_diff_combine(const bf16_t* OB1, bf16_t* OBN, const float* lq1, const float* lk1, const float* lq2, const float* lk2, const float* g) {
    const int lane = threadIdx.x & 63, gw = blockIdx.x * 4 + (threadIdx.x >> 6), NGW = gridDim.x * 4;
    const float s1 = wave_sum(lq1[lane] * lk1[lane]), s2 = wave_sum(lq2[lane] * lk2[lane]);
    const float lam = expf(s1) - expf(s2) + 0.2f;
    const float g0 = g[2 * lane], g1 = g[2 * lane + 1];
    for (int m = gw; m < M; m += NGW) {
#pragma unroll
        for (int h = 0; h < 4; ++h) {
            const unsigned a = *(const unsigned*)(OB1 + (size_t)m * 1024 + (2 * h) * 128 + 2 * lane);
            const unsigned c = *(const unsigned*)(OB1 + (size_t)m * 1024 + (2 * h + 1) * 128 + 2 * lane);
            const float v0 = bf2f((bf16_t)(a & 0xffff)) - lam * bf2f((bf16_t)(c & 0xffff)), v1 = bf2f((bf16_t)(a >> 16)) - lam * bf2f((bf16_t)(c >> 16));
            const float ss = wave_sum(v0 * v0 + v1 * v1);
            const float rs = 0.8f / sqrtf(ss * (1.f / 128.f) + 1e-5f);
            *(unsigned*)(OBN + (size_t)m * 512 + h * 128 + 2 * lane) = pk2(v0 * rs * g0, v1 * rs * g1);
        }
    }
}

namespace pg8 {
#define PG8_LAS __attribute__((address_space(3)))
typedef unsigned short bf16_t;
typedef short bf16x8 __attribute__((ext_vector_type(8)));
typedef float f32x4 __attribute__((ext_vector_type(4)));
typedef unsigned u32x4 __attribute__((ext_vector_type(4)));
constexpr int BM = 256, BK = 64, HALF = 128, HTB = HALF * BK * 2  , STAGE_BYTES = 8 * HTB, NXCD = 8, WGM = 8;

__host__ __device__ __forceinline__ int lds_byte(int r, int c) { const int st = (r >> 4) * 2 + (c >> 5), rr = r & 15, cc = c & 31, ob = rr * 64 + cc * 2; return st * 1024 + (ob ^ (((ob >> 9) & 1) << 5)); }
__host__ __device__ __forceinline__ void stage_rc(int b, int& R, int& C) { const int st = b / 1024, sb = b % 1024, swz = sb ^ (((sb >> 9) & 1) << 5); R = (st >> 1) * 16 + swz / 64; C = (st & 1) * 32 + (swz % 64) / 2; }
__host__ __device__ __forceinline__ int perm32(int rho) { const int n = rho >> 4, i = rho & 15; return 8 * (i >> 2) + 4 * n + (i & 3); }

struct Unit { int pm, pn; };
struct Gemm { const bf16_t* A; const bf16_t* Bt; int M, N, K; };

struct StaticOrder {
    int nM, nN, nwg, G, c;
    __host__ __device__ void init(int M, int N, int G_, int c_) { nM = M / BM; nN = N / BM; nwg = nM * nN; G = G_; c = c_; }
    __host__ __device__ bool next(int i, Unit& u) const {
        const long L = (long)i * G + c; if (L >= nwg) return false;
        int wgid = (int)L; { const int q = nwg / NXCD, r = nwg % NXCD, xcd = wgid % NXCD, off = wgid / NXCD; wgid = (xcd < r ? xcd * (q + 1) : r * (q + 1) + (xcd - r) * q) + off; }
        const int nig = WGM * nN, gid = wgid / nig, fm = gid * WGM, gsz = (nM - fm) < WGM ? (nM - fm) : WGM;
        u.pm = fm + ((wgid % nig) % gsz); u.pn = (wgid % nig) / gsz; return true;
    }
    __device__ __forceinline__ void a_ready(const Unit&) const {}
    __device__ __forceinline__ void done(const Unit&) const {}
};

__device__ __forceinline__ unsigned cvt_pk_bf16(float lo, float hi) { unsigned r; asm volatile("v_cvt_pk_bf16_f32 %0, %1, %2" : "=v"(r) : "v"(lo), "v"(hi)); return r; }
template <class Epi, class Sched, bool ALIGN_EPI = false, bool SP2 = false>
__device__ __forceinline__ void gemm_phase(PG8_LAS unsigned char* lds, const Gemm g, const Sched& S, const Epi& E, const int wid_s) {
    const int tid = wid_s * 64 + lane_id_asm(), wid = wid_s, lane = tid & 63, wr = wid >> 2, wc = wid & 3, fr = lane & 15, fq = lane >> 4;
    const int K = g.K, nt = K / BK;
    unsigned voffA[2], voffB[2];
#pragma unroll
    for (int i = 0; i < 2; ++i) { int R, C; stage_rc(tid * 16 + i * 8192, R, C); const int Rb = Epi::PERM ? ((R & ~31) + perm32(R & 31)) : R;
        voffA[i] = (unsigned)(R * K + C) * 2u; voffB[i] = (unsigned)(Rb * K + C) * 2u; }
    const size_t kstep = (size_t)(BK * 2);
    const size_t hstep = (size_t)HALF * K * 2;
    const size_t tstep = 2 * hstep;
    const unsigned ldsw = (unsigned)wid * 1024u;
    const int aoff = lds_byte(wr * 64 + fr, fq * 8), boff = lds_byte(wc * 32 + fr, fq * 8);
#define PG8_SA(b, h) (((b) * 2 + (h)) * HTB)
#define PG8_SB(b, h) ((4 + (b) * 2 + (h)) * HTB)
#define PG8_STAGE(bufoff, gbase, voff) do { _Pragma("unroll") for (int _i = 0; _i < 2; ++_i) \
        __builtin_amdgcn_global_load_lds((const unsigned*)((const char*)(gbase) + (voff)[_i]), (PG8_LAS unsigned*)(lds + (bufoff) + ldsw + _i * 8192), 16, 0, 0); } while (0)
#define PG8_LDA(dst, b, h) do { _Pragma("unroll") for (int m = 0; m < 4; ++m) _Pragma("unroll") for (int k = 0; k < 2; ++k) dst[m][k] = *(const PG8_LAS bf16x8*)(lds + PG8_SA(b, h) + aoff + m * 2048 + k * 1024); } while (0)
#define PG8_LDB(dst, b, h) do { _Pragma("unroll") for (int n = 0; n < 2; ++n) _Pragma("unroll") for (int k = 0; k < 2; ++k) dst[n][k] = *(const PG8_LAS bf16x8*)(lds + PG8_SB(b, h) + boff + n * 2048 + k * 1024); } while (0)
#define PG8_MMA(ai, bj, At, Bt) do { __builtin_amdgcn_s_setprio(1); _Pragma("unroll") for (int m = 0; m < 4; ++m) _Pragma("unroll") for (int n = 0; n < 2; ++n) _Pragma("unroll") for (int k = 0; k < 2; ++k) \
        acc[ai][bj][m][n] = __builtin_amdgcn_mfma_f32_16x16x32_bf16(Bt[n][k], At[m][k], acc[ai][bj][m][n], 0, 0, 0); __builtin_amdgcn_s_setprio(0); } while (0)
#define PG8_WAIT_V(n) asm volatile("s_waitcnt vmcnt(" #n ")" ::: "memory")
#define PG8_WAIT_L(n) asm volatile("s_waitcnt lgkmcnt(" #n ")" ::: "memory")
#define PG8_BAR __builtin_amdgcn_s_barrier()
#define PG8_SCHED __builtin_amdgcn_sched_barrier(0)
    Unit cur, nxt; int ui = 0;
    if (!S.next(0, cur)) return;
    f32x4 acc[2][2][4][2];
#pragma unroll
    for (int a = 0; a < 2; ++a)
#pragma unroll
        for (int b = 0; b < 2; ++b)
#pragma unroll
            for (int m = 0; m < 4; ++m)
#pragma unroll
                for (int n = 0; n < 2; ++n) acc[a][b][m][n] = (f32x4){0.f, 0.f, 0.f, 0.f};
    bf16x8 At[4][2], B0[2][2], B1[2][2];
    const char* cA = (const char*)g.A + (size_t)cur.pm * tstep; const char* cB = (const char*)g.Bt + (size_t)cur.pn * tstep;
    S.a_ready(cur);
    if constexpr (SP2) {
        PG8_STAGE(PG8_SB(0, 0), cB, voffB); PG8_STAGE(PG8_SB(0, 1), cB + hstep, voffB); PG8_STAGE(PG8_SA(0, 0), cA, voffA); PG8_STAGE(PG8_SA(0, 1), cA + hstep, voffA);
        if (wr == 1) PG8_BAR;
        PG8_WAIT_V(2); PG8_BAR;
        PG8_STAGE(PG8_SB(1, 0), cB + kstep, voffB); PG8_STAGE(PG8_SA(1, 0), cA + kstep, voffA); PG8_STAGE(PG8_SB(1, 1), cB + hstep + kstep, voffB);
        PG8_WAIT_V(6); PG8_BAR;
    } else {
        PG8_STAGE(PG8_SB(0, 0), cB, voffB); PG8_STAGE(PG8_SA(0, 0), cA, voffA); PG8_STAGE(PG8_SB(0, 1), cB + hstep, voffB); PG8_STAGE(PG8_SA(0, 1), cA + hstep, voffA);
        if (wr == 1) PG8_BAR;
        PG8_WAIT_V(4); PG8_BAR;
        PG8_STAGE(PG8_SB(1, 0), cB + kstep, voffB); PG8_STAGE(PG8_SA(1, 0), cA + kstep, voffA); PG8_STAGE(PG8_SB(1, 1), cB + hstep + kstep, voffB);
        PG8_WAIT_V(6); PG8_BAR;
    }
    for (;;) {
        const bool has_next = S.next(ui + 1, nxt);
        const char* nA = has_next ? (const char*)g.A + (size_t)nxt.pm * tstep : cA; const char* nB = has_next ? (const char*)g.Bt + (size_t)nxt.pn * tstep : cB;
        for (int t = 0; t < nt; t += 2) {
            const bool last = (t == nt - 2);
            const char* a1 = cA + (size_t)(t + 1) * kstep;
            const char* a2 = last ? nA : cA + (size_t)(t + 2) * kstep; const char* b2 = last ? nB : cB + (size_t)(t + 2) * kstep;
            const char* a3 = a2 + kstep; const char* b3 = b2 + kstep;
            if (last && has_next) S.a_ready(nxt);
            if constexpr (SP2) {
            PG8_LDB(B0, 0, 0); PG8_LDB(B1, 0, 1); PG8_SCHED; PG8_LDA(At, 0, 0); PG8_STAGE(PG8_SA(1, 1), a1 + hstep, voffA);
            PG8_WAIT_V(8); PG8_WAIT_L(0); PG8_BAR; PG8_MMA(0, 0, At, B0); PG8_MMA(0, 1, At, B1); PG8_BAR; PG8_SCHED;
            PG8_LDA(At, 0, 1); PG8_STAGE(PG8_SB(0, 0), b2, voffB); PG8_STAGE(PG8_SB(0, 1), b2 + hstep, voffB); PG8_STAGE(PG8_SA(0, 0), a2, voffA);
            PG8_WAIT_V(8); PG8_WAIT_L(0); PG8_BAR; PG8_MMA(1, 0, At, B0); PG8_MMA(1, 1, At, B1); PG8_BAR; PG8_SCHED;
            PG8_LDB(B0, 1, 0); PG8_LDB(B1, 1, 1); PG8_SCHED; PG8_LDA(At, 1, 0); PG8_STAGE(PG8_SA(0, 1), a2 + hstep, voffA);
            PG8_WAIT_V(8); PG8_WAIT_L(0); PG8_BAR; PG8_MMA(0, 0, At, B0); PG8_MMA(0, 1, At, B1); PG8_BAR; PG8_SCHED;
            PG8_LDA(At, 1, 1); PG8_STAGE(PG8_SB(1, 0), b3, voffB); PG8_STAGE(PG8_SB(1, 1), b3 + hstep, voffB); PG8_STAGE(PG8_SA(1, 0), a3, voffA);
            PG8_WAIT_V(8); PG8_WAIT_L(0); PG8_BAR; PG8_MMA(1, 0, At, B0); PG8_MMA(1, 1, At, B1); PG8_BAR; PG8_SCHED;
            } else {
            PG8_LDB(B0, 0, 0); PG8_SCHED; PG8_LDA(At, 0, 0); PG8_STAGE(PG8_SA(1, 1), a1 + hstep, voffA);
            PG8_WAIT_L(8); PG8_BAR; PG8_WAIT_L(0); PG8_MMA(0, 0, At, B0); PG8_BAR; PG8_SCHED;
            PG8_LDB(B1, 0, 1); PG8_STAGE(PG8_SB(0, 0), b2, voffB);
            PG8_BAR; PG8_WAIT_L(0); PG8_MMA(0, 1, At, B1); PG8_BAR;
            PG8_LDA(At, 0, 1); PG8_STAGE(PG8_SA(0, 0), a2, voffA);
            PG8_BAR; PG8_WAIT_L(0); PG8_MMA(1, 0, At, B0); PG8_BAR; PG8_SCHED;
            PG8_STAGE(PG8_SB(0, 1), b2 + hstep, voffB);
            PG8_WAIT_V(6); PG8_BAR; PG8_MMA(1, 1, At, B1); PG8_BAR;
            PG8_LDB(B0, 1, 0); PG8_SCHED; PG8_LDA(At, 1, 0); PG8_STAGE(PG8_SA(0, 1), a2 + hstep, voffA);
            PG8_WAIT_L(8); PG8_BAR; PG8_WAIT_L(0); PG8_MMA(0, 0, At, B0); PG8_BAR; PG8_SCHED;
            PG8_LDB(B1, 1, 1); PG8_STAGE(PG8_SB(1, 0), b3, voffB);
            PG8_BAR; PG8_WAIT_L(0); PG8_MMA(0, 1, At, B1); PG8_BAR;
            PG8_LDA(At, 1, 1); PG8_STAGE(PG8_SA(1, 0), a3, voffA);
            PG8_BAR; PG8_WAIT_L(0); PG8_MMA(1, 0, At, B0); PG8_BAR; PG8_SCHED;
            PG8_STAGE(PG8_SB(1, 1), b3 + hstep, voffB);
            PG8_WAIT_V(6); PG8_BAR; PG8_MMA(1, 1, At, B1); PG8_BAR;
            }
        }
        if constexpr (ALIGN_EPI) { if (wr == 0) PG8_BAR; }
        if constexpr (!Epi::AFTER_DRAIN) { E(acc, cur, wr, wc, fr, fq); S.done(cur); __builtin_amdgcn_s_waitcnt(0x0F70);   }
        if (!has_next) break;
#pragma unroll
        for (int a = 0; a < 2; ++a)
#pragma unroll
            for (int b = 0; b < 2; ++b)
#pragma unroll
                for (int m = 0; m < 4; ++m)
#pragma unroll
                    for (int n = 0; n < 2; ++n) acc[a][b][m][n] = (f32x4){0.f, 0.f, 0.f, 0.f};
        cur = nxt; cA = nA; cB = nB; ++ui;
        if constexpr (ALIGN_EPI) { if (wr == 1) PG8_BAR; }
    }
    PG8_WAIT_V(0);
    if constexpr (!ALIGN_EPI) { if (wr == 0) PG8_BAR; }
    PG8_BAR;
    if constexpr (Epi::AFTER_DRAIN) { E.fused(acc, cur, wr, wc, fr, fq, lds, wid, lane); S.done(cur); }
#undef PG8_SA
#undef PG8_SB
#undef PG8_STAGE
#undef PG8_LDA
#undef PG8_LDB
#undef PG8_MMA
#undef PG8_WAIT_V
#undef PG8_WAIT_L
#undef PG8_BAR
#undef PG8_SCHED
}
}
#include <hip/hip_bf16.h>
#include <cmath>
namespace attn_body {
using bf16=__hip_bfloat16;
using bf16x8=__attribute__((ext_vector_type(8)))short;
using s16x4=__attribute__((ext_vector_type(4)))short;
using f32x16=__attribute__((ext_vector_type(16)))float;
using u32x4=__attribute__((ext_vector_type(4)))unsigned;
constexpr int BATCH=2,NHEAD=16,SEQ=8192,D=64,DM=NHEAD*D;
constexpr int NW=8,QBLK=32,QB=QBLK*NW,KVBLK=64,NQB=SEQ/QB;
constexpr int ATTN_PITCH=DM, ATTN_UNIT_ROWS=QB;
__device__ __forceinline__ int crow(int r,int hi){return (r&3)+8*(r>>2)+4*hi;}
#define SBAR() __builtin_amdgcn_sched_barrier(0)
__device__ __forceinline__ void cmask(f32x16&p0,f32x16&p1,int jb,int qrel,int hi){
  const float NEG=-INFINITY; int kb=64*jb+4*hi;
  #pragma unroll
  for(int r=0;r<16;++r){int kv=kb+(r&3)+8*(r>>2); if(kv>qrel)p0[r]=NEG; if(kv+32>qrel)p1[r]=NEG;}
}

constexpr int NSLOT=3, SLOTB=8192;
constexpr int LDS_K=0, LDS_V=NSLOT*SLOTB, LDS_WS=2*NSLOT*SLOTB, LDS_OST=LDS_WS+NW*64*4, LDS_BYTES=LDS_OST+NW*4096;
constexpr float C2=0.125f*1.4426950408889634f;
__device__ __forceinline__ void glds16(const void*gsrc,unsigned lds_dst){unsigned keep;
  asm volatile("s_mov_b32 %0, m0\n\ts_mov_b32 m0, %2\n\ts_nop 0\n\tglobal_load_lds_dwordx4 %1, off\n\ts_mov_b32 m0, %0":"=&s"(keep):"v"(gsrc),"s"(lds_dst):"memory");}
__device__ __forceinline__ float max3f(float a,float b,float c){float r;asm("v_max3_f32 %0, %1, %2, %3":"=v"(r):"v"(a),"v"(b),"v"(c));return r;}
__device__ __forceinline__ float max2f(float a,float b){float r;asm("v_max_f32_e32 %0, %1, %2":"=v"(r):"v"(a),"v"(b));return r;}
__device__ __forceinline__ float fadd_s(float a,float b){float r;asm("v_add_f32_e32 %0, %1, %2":"=v"(r):"v"(a),"v"(b));return r;}
__device__ __forceinline__ float fsub_s(float a,float b){float r;asm("v_sub_f32_e32 %0, %1, %2":"=v"(r):"v"(a),"v"(b));return r;}
typedef float f32x2_t __attribute__((ext_vector_type(2))); typedef __bf16 bf16x2_t __attribute__((ext_vector_type(2)));
__device__ __forceinline__ unsigned cvtpk_s(float lo,float hi){f32x2_t v={lo,hi};bf16x2_t b=__builtin_convertvector(v,bf16x2_t);return __builtin_bit_cast(unsigned,b);}
#define WAIT_BAR(N) asm volatile("s_waitcnt vmcnt(" #N ") lgkmcnt(0)\n\ts_barrier":::"memory")

__device__ __forceinline__ void qkt(f32x16&p0,f32x16&p1,const char*Kslot,const bf16x8*qr,const f32x16&negm,int r32,int hi){
  const char*kb=Kslot+hi*1024+r32*16;
  #pragma unroll
  for(int d0=0;d0<4;++d0){
    const bf16x8 b0=*reinterpret_cast<const bf16x8*>(kb+d0*2048);
    const bf16x8 b1=*reinterpret_cast<const bf16x8*>(kb+d0*2048+512);
    if(d0==0){p0=__builtin_amdgcn_mfma_f32_32x32x16_bf16(b0,qr[0],negm,0,0,0);p1=__builtin_amdgcn_mfma_f32_32x32x16_bf16(b1,qr[0],negm,0,0,0);}
    else{p0=__builtin_amdgcn_mfma_f32_32x32x16_bf16(b0,qr[d0],p0,0,0,0);p1=__builtin_amdgcn_mfma_f32_32x32x16_bf16(b1,qr[d0],p1,0,0,0);}}
}
typedef __attribute__((address_space(3))) const char* lds_cptr;
typedef short v4i16_t __attribute__((ext_vector_type(4)));
__device__ __forceinline__ void kload8(bf16x8*kf,lds_cptr kp){
  kf[0]=*(const __attribute__((address_space(3))) bf16x8*)(kp);      kf[1]=*(const __attribute__((address_space(3))) bf16x8*)(kp+512);
  kf[2]=*(const __attribute__((address_space(3))) bf16x8*)(kp+2048); kf[3]=*(const __attribute__((address_space(3))) bf16x8*)(kp+2560);
  kf[4]=*(const __attribute__((address_space(3))) bf16x8*)(kp+4096); kf[5]=*(const __attribute__((address_space(3))) bf16x8*)(kp+4608);
  kf[6]=*(const __attribute__((address_space(3))) bf16x8*)(kp+6144); kf[7]=*(const __attribute__((address_space(3))) bf16x8*)(kp+6656);
}
__device__ __forceinline__ void kload2(bf16x8*kf,lds_cptr kp,int j){ kf[2*j]=*(const __attribute__((address_space(3))) bf16x8*)(kp+j*2048); kf[2*j+1]=*(const __attribute__((address_space(3))) bf16x8*)(kp+j*2048+512); }
__device__ __forceinline__ s16x4 vtr(lds_cptr p){ return __builtin_bit_cast(s16x4,__builtin_amdgcn_ds_read_tr16_b64_v4i16((__attribute__((address_space(3))) v4i16_t*)p)); }
__device__ __forceinline__ float rowmax(const f32x16&p0,const f32x16&p1){
  float a=max3f(p0[0],p0[1],p1[0]),b=max3f(p0[2],p0[3],p1[1]);a=max3f(a,p1[2],p1[3]);
  #pragma unroll
  for(int r=4;r<16;r+=4){a=max3f(a,p0[r],p0[r+1]);b=max3f(b,p0[r+2],p0[r+3]);a=max3f(a,p1[r],p1[r+1]);b=max3f(b,p1[r+2],p1[r+3]);}
  const float m=max2f(a,b);
  auto rr=__builtin_amdgcn_permlane32_swap(__float_as_uint(m),__float_as_uint(m),false,false);
  return max2f(__uint_as_float(rr[0]),__uint_as_float(rr[1]));
}
__device__ __forceinline__ void pv(f32x16*o,int vb,bf16x8 pa0,bf16x8 pa1,bf16x8 pa2,bf16x8 pa3){
  #pragma unroll
  for(int d0=0;d0<2;++d0){s16x4 lo[4],hi[4];
    #pragma unroll
    for(int ks=0;ks<4;++ks){
      asm volatile("ds_read_b64_tr_b16 %0,%1 offset:%c2":"=&v"(lo[ks]):"v"(vb),"i"(d0*4096+ks*1024):"memory");
      asm volatile("ds_read_b64_tr_b16 %0,%1 offset:%c2":"=&v"(hi[ks]):"v"(vb),"i"(d0*4096+ks*1024+512):"memory");}
    asm volatile("s_waitcnt lgkmcnt(0)":::"memory");SBAR();
    #define PK(k) (bf16x8){lo[k][0],lo[k][1],lo[k][2],lo[k][3],hi[k][0],hi[k][1],hi[k][2],hi[k][3]}
    o[d0]=__builtin_amdgcn_mfma_f32_32x32x16_bf16(pa0,PK(0),o[d0],0,0,0);
    o[d0]=__builtin_amdgcn_mfma_f32_32x32x16_bf16(pa1,PK(1),o[d0],0,0,0);
    o[d0]=__builtin_amdgcn_mfma_f32_32x32x16_bf16(pa2,PK(2),o[d0],0,0,0);
    o[d0]=__builtin_amdgcn_mfma_f32_32x32x16_bf16(pa3,PK(3),o[d0],0,0,0);
    #undef PK
  }
}

__device__ __forceinline__ float mand(float x,unsigned w,int c){ const int m=((int)(w<<(31-c)))>>31; return __int_as_float(__float_as_int(x)&m); }
#define MBIT(r) (((r)&3)+8*((r)>>2))
#ifndef ATTN_STORE16
#define ATTN_STORE16(p,v) (*(u32x4*)(p)=(v))
#endif
template<int THRL,int QP,int KP,int VP,int OP,bool MASKED> __device__ __forceinline__ void attn_unit(int b,int qb,const bf16*Q,const bf16*__restrict__ K,const bf16*__restrict__ V,bf16*O,const unsigned long long*MK,char*shm,const int wid_s){
  const int lane=lane_id_asm(),tid=wid_s*64+lane,r32=lane&31,hi=lane>>5; const int wid=wid_s; (void)tid;
  const long rowbase=(long)b*SEQ; const int q0=qb*QB;
  const bf16*Qw=Q+(rowbase+q0+wid*QBLK)*QP;
  const bf16*Kh=K+rowbase*KP,*Vh=V+rowbase*VP;
  const unsigned lds0=(unsigned)(uintptr_t)shm;
  float*wsf=(float*)(shm+LDS_WS)+wid*64;
  const bf16*ksrc=Kh+(long)lane*KP+wid*8;
  const bf16*vsrc=Vh+(long)(16*(wid&3)+(lane>>2))*VP+(wid>>2)*32+(lane&3)*8;
  const unsigned kdst=lds0+LDS_K+wid*1024, vdst=lds0+LDS_V+wid*1024;
  #define DMA_K(t,slot) glds16(ksrc+(long)(t)*KVBLK*KP,(unsigned)__builtin_amdgcn_readfirstlane(kdst+(slot)))
  #define DMA_V(t,slot) glds16(vsrc+(long)(t)*KVBLK*VP,(unsigned)__builtin_amdgcn_readfirstlane(vdst+(slot)))
  const int vb0=(int)(lds0+LDS_V)+((lane>>4)&1)*32+(lane&3)*8+(4*hi+((lane&15)>>2))*64;
  const char*Kbase=shm+LDS_K; bf16x8 kf[8];
  const lds_cptr shm3=(lds_cptr)shm; const lds_cptr kp0=shm3+LDS_K+hi*1024+r32*16; const lds_cptr vp0=shm3+LDS_V+((lane>>4)&1)*32+(lane&3)*8+(4*hi+((lane&15)>>2))*64;
  const int NT=(q0+QB)/KVBLK;
  DMA_K(0,0);DMA_V(0,0);DMA_K(1,SLOTB);
  const unsigned long long*mkw=MK+((rowbase+q0+wid*QBLK)<<7);
  const unsigned long long*mkp=mkw+(r32<<7);
  unsigned mlo=0u,mhi=0u,nlo=0u,nhi=0u;
  if(MASKED){ const unsigned long long w0=mkp[0],w1=mkp[1]; mlo=(unsigned)w0>>(4*hi); mhi=(unsigned)(w0>>32)>>(4*hi); nlo=(unsigned)w1>>(4*hi); nhi=(unsigned)(w1>>32)>>(4*hi); }
  bf16x8 qr[4];
  #pragma unroll
  for(int d0=0;d0<4;++d0)qr[d0]=*reinterpret_cast<const bf16x8*>(&Qw[(long)r32*QP+d0*16+hi*8]);
  float zf_; asm volatile("v_mov_b32 %0, 0":"=v"(zf_));
  float mhat=zf_,l_reg=zf_;f32x16 o[2];
  _Pragma("unroll") for(int r=0;r<16;++r){o[0][r]=zf_;o[1][r]=zf_;}
  f32x16 negm; _Pragma("unroll") for(int r=0;r<16;++r)negm[r]=zf_; asm volatile("":"+v"(negm));
  const int qrel=wid*QBLK+r32;
  #define CMASK(P0,P1,t) do{ if(!MASKED){ int jb_=(t)-(NT-4); if(jb_>=0)cmask(P0,P1,jb_,qrel,hi);} }while(0)
  bool resc=false;
  #define START(P0,P1) do{ const float rm=rowmax(P0,P1); resc=false; \
    { const float dl=rm; mhat=fadd_s(mhat,dl); \
      _Pragma("unroll") for(int r=0;r<16;++r){P0[r]=fsub_s(P0[r],dl);P1[r]=fsub_s(P1[r],dl);} \
      _Pragma("unroll") for(int r=0;r<16;++r)negm[r]=-mhat; asm volatile("":"+v"(negm)); } \
    _Pragma("unroll") for(int r=0;r<16;++r){P0[r]=__builtin_amdgcn_exp2f(P0[r]); if(MASKED)P0[r]=mand(P0[r],mlo,MBIT(r));} }while(0)
  #define RESC() do{ if(resc){ asm volatile("s_waitcnt lgkmcnt(0)":::"memory"); \
      _Pragma("unroll") for(int d_=0;d_<2;++d_) _Pragma("unroll") for(int r=0;r<16;++r)o[d_][r]*=wsf[crow(r,hi)]; } }while(0)
  f32x16 pA0,pA1,pB0,pB1;
  int sl_prev=0,sl_cur=0,sl_next=SLOTB;
  #define ROT() do{sl_prev=sl_cur;sl_cur=sl_next;sl_next=(sl_next==(NSLOT-1)*SLOTB)?0:sl_next+SLOTB;}while(0)
  DMA_K(2,2*SLOTB);
  WAIT_BAR(3);
  qkt(pA0,pA1,Kbase,qr,negm,r32,hi);asm volatile("s_nop 15\n\ts_nop 7":"+v"(pA0),"+v"(pA1));CMASK(pA0,pA1,0);
  START(pA0,pA1);
  _Pragma("unroll") for(int r=0;r<16;++r){pA1[r]=__builtin_amdgcn_exp2f(pA1[r]); if(MASKED)pA1[r]=mand(pA1[r],mhi,MBIT(r));}
  WAIT_BAR(0);
  DMA_K(3,0);DMA_V(1,SLOTB);
  ROT();
  if(MASKED){mlo=nlo;mhi=nhi;}
  kload8(kf,kp0+sl_cur);
  WAIT_BAR(2);
  s16x4 vlo[8],vhi[8]; u32x4 pw0,pw1,pw2,pw3; unsigned long long nw=0ull;
  #define MROT() do{ if(MASKED){ asm volatile("":"+v"(nw)); mlo=(unsigned)nw>>(4*hi); mhi=(unsigned)(nw>>32)>>(4*hi); } }while(0)
  #define PKW(P,B) cvtpk_s(P[B],P[B+1])
  #define PAF(k) __builtin_bit_cast(bf16x8,pw##k)
  #define VFR(i) (bf16x8){vlo[i][0],vlo[i][1],vlo[i][2],vlo[i][3],vhi[i][0],vhi[i][1],vhi[i][2],vhi[i][3]}
  #define PIN(x) asm volatile("":"+v"(x))
  #define MX3(a,b,c) __builtin_fmaxf(__builtin_fmaxf((a),(b)),(c))
  #define GAPA(MF,A0,A1,A2,A3,W0,W1,PW) do{ MF; sacc+=A0; sacc+=A1; sacc+=A2; sacc+=A3; PIN(sacc); W0; W1; PIN(PW); SBAR(); }while(0)
  #define EX(v) __builtin_amdgcn_exp2f(v)
  #define GAPB(MF,X,B,W) do{ MF; X[B]=EX(X[B]); X[B+1]=EX(X[B+1]); X[B+2]=EX(X[B+2]); X[B+3]=EX(X[B+3]); if(MASKED){X[B]=mand(X[B],W,MBIT(B));X[B+1]=mand(X[B+1],W,MBIT(B+1));X[B+2]=mand(X[B+2],W,MBIT(B+2));X[B+3]=mand(X[B+3],W,MBIT(B+3));} PIN(X); SBAR(); }while(0)
  #define VRD(i) do{ vlo[i]=vtr(vp_+(((i)>>2)*4096+((i)&3)*1024)); vhi[i]=vtr(vp_+(((i)>>2)*4096+((i)&3)*1024+512)); }while(0)
  #define KRD(G,j) do{ if(G){ kload2(kf,kp0+sl_next,j); SBAR(); } }while(0)
  #define STEP(C0,C1,P0,P1,t,GK,GV,GL) do{ SBAR(); \
    if(MASKED&&(GV)){ const unsigned vo_=(unsigned)(r32<<10)+8u*(unsigned)((t)+1); asm volatile("global_load_dwordx2 %0, %1, %2":"=&v"(nw):"v"(vo_),"s"(mkw):"memory"); } \
    const lds_cptr vp_=vp0+sl_prev; \
    VRD(0); SBAR(); float sacc=(P0[0]+P0[1]); \
    GAPA(C0=__builtin_amdgcn_mfma_f32_32x32x16_bf16(kf[0],qr[0],negm,0,0,0), P0[2],P0[3],P0[4],P0[5],     pw0[0]=PKW(P0,0), pw0[1]=PKW(P0,2), pw0); \
    VRD(4); SBAR(); GAPA(C1=__builtin_amdgcn_mfma_f32_32x32x16_bf16(kf[1],qr[0],negm,0,0,0), P0[6],P0[7],P0[8],P0[9],     pw0[2]=PKW(P0,4), pw0[3]=PKW(P0,6), pw0); \
    VRD(1); SBAR(); GAPA(C0=__builtin_amdgcn_mfma_f32_32x32x16_bf16(kf[2],qr[1],C0,0,0,0),   P0[10],P0[11],P0[12],P0[13], pw1[0]=PKW(P0,8), pw1[1]=PKW(P0,10), pw1); \
    VRD(5); SBAR(); GAPA(C1=__builtin_amdgcn_mfma_f32_32x32x16_bf16(kf[3],qr[1],C1,0,0,0),   P0[14],P0[15],P1[0],P1[1],   pw1[2]=PKW(P0,12),pw1[3]=PKW(P0,14), pw1); \
    VRD(2); SBAR(); GAPA(C0=__builtin_amdgcn_mfma_f32_32x32x16_bf16(kf[4],qr[2],C0,0,0,0),   P1[2],P1[3],P1[4],P1[5],     pw2[0]=PKW(P1,0), pw2[1]=PKW(P1,2), pw2); \
    VRD(6); SBAR(); GAPA(C1=__builtin_amdgcn_mfma_f32_32x32x16_bf16(kf[5],qr[2],C1,0,0,0),   P1[6],P1[7],P1[8],P1[9],     pw2[2]=PKW(P1,4), pw2[3]=PKW(P1,6), pw2); \
    VRD(3); SBAR(); GAPA(C0=__builtin_amdgcn_mfma_f32_32x32x16_bf16(kf[6],qr[3],C0,0,0,0),   P1[10],P1[11],P1[12],P1[13], pw3[0]=PKW(P1,8), pw3[1]=PKW(P1,10), pw3); \
    VRD(7); SBAR(); GAPA(C1=__builtin_amdgcn_mfma_f32_32x32x16_bf16(kf[7],qr[3],C1,0,0,0),   P1[14],P1[15],0.f,0.f,       pw3[2]=PKW(P1,12),pw3[3]=PKW(P1,14), pw3); \
    l_reg+=sacc; \
    if(GK){DMA_K((t)+3,sl_cur);} if(GV){DMA_V((t)+1,sl_next);} \
    CMASK(C0,C1,t); \
    { float a=MX3(C0[0],C0[1],C1[0]),b=MX3(C0[2],C0[3],C1[1]); a=MX3(a,C1[2],C1[3]); \
      _Pragma("unroll") for(int r=4;r<16;r+=4){a=MX3(a,C0[r],C0[r+1]);b=MX3(b,C0[r+2],C0[r+3]);a=MX3(a,C1[r],C1[r+1]);b=MX3(b,C1[r+2],C1[r+3]);} \
      float rm=__builtin_fmaxf(a,b); { auto rr=__builtin_amdgcn_permlane32_swap(__float_as_uint(rm),__float_as_uint(rm),false,false); rm=__builtin_fmaxf(__uint_as_float(rr[0]),__uint_as_float(rr[1])); } \
      resc=false; \
      if(__builtin_expect(__any(rm>(float)THRL),0)){ const float dl=__builtin_fmaxf(rm,0.f); mhat+=dl; \
        _Pragma("unroll") for(int r=0;r<16;++r){C0[r]-=dl;C1[r]-=dl;} \
        _Pragma("unroll") for(int r=0;r<16;++r)negm[r]=-mhat; asm volatile("":"+v"(negm)); \
        const float f=__builtin_amdgcn_exp2f(-dl); l_reg*=f; if(hi==0)wsf[r32]=f; resc=true; } } \
    SBAR(); \
    GAPB(o[0]=__builtin_amdgcn_mfma_f32_32x32x16_bf16(PAF(0),VFR(0),o[0],0,0,0), C0,0,mlo); \
    GAPB(o[1]=__builtin_amdgcn_mfma_f32_32x32x16_bf16(PAF(0),VFR(4),o[1],0,0,0), C0,4,mlo); \
    KRD(GL,0); GAPB(o[0]=__builtin_amdgcn_mfma_f32_32x32x16_bf16(PAF(1),VFR(1),o[0],0,0,0), C0,8,mlo); \
    KRD(GL,1); GAPB(o[1]=__builtin_amdgcn_mfma_f32_32x32x16_bf16(PAF(1),VFR(5),o[1],0,0,0), C0,12,mlo); \
    KRD(GL,2); GAPB(o[0]=__builtin_amdgcn_mfma_f32_32x32x16_bf16(PAF(2),VFR(2),o[0],0,0,0), C1,0,mhi); \
    KRD(GL,3); GAPB(o[1]=__builtin_amdgcn_mfma_f32_32x32x16_bf16(PAF(2),VFR(6),o[1],0,0,0), C1,4,mhi); \
    GAPB(o[0]=__builtin_amdgcn_mfma_f32_32x32x16_bf16(PAF(3),VFR(3),o[0],0,0,0), C1,8,mhi); \
    GAPB(o[1]=__builtin_amdgcn_mfma_f32_32x32x16_bf16(PAF(3),VFR(7),o[1],0,0,0), C1,12,mhi); \
    }while(0)
  int t=1;
  #undef CMASK
  #define CMASK(P0,P1,t) do{}while(0)
  for(;t+5<NT;t+=2){
    STEP(pB0,pB1,pA0,pA1,t,true,true,true);     WAIT_BAR(2); MROT(); RESC(); ROT();
    STEP(pA0,pA1,pB0,pB1,t+1,true,true,true);   WAIT_BAR(2); MROT(); RESC(); ROT();
  }
  #undef CMASK
  #define CMASK(P0,P1,t) do{ if(!MASKED){ int jb_=(t)-(NT-4); if(jb_>=0)cmask(P0,P1,jb_,qrel,hi);} }while(0)
  #define ENDW(tt) do{ if((tt)+3<NT){WAIT_BAR(2);} else if((tt)+2<NT){WAIT_BAR(1);} else {WAIT_BAR(0);} }while(0)
  for(;t+1<NT;t+=2){
    STEP(pB0,pB1,pA0,pA1,t,(t+3<NT),(t+1<NT),(t+1<NT));       ENDW(t);   MROT(); RESC(); ROT();
    STEP(pA0,pA1,pB0,pB1,t+1,(t+4<NT),(t+2<NT),(t+2<NT));     ENDW(t+1); MROT(); RESC(); ROT();
  }
  STEP(pB0,pB1,pA0,pA1,NT-1,false,false,false); RESC();
  { float sacc=pB0[0]+pB0[1]; _Pragma("unroll") for(int r=2;r<16;++r)sacc+=pB0[r]; _Pragma("unroll") for(int r=0;r<16;++r)sacc+=pB1[r]; l_reg+=sacc;
    pw0=(u32x4){PKW(pB0,0),PKW(pB0,2),PKW(pB0,4),PKW(pB0,6)};pw1=(u32x4){PKW(pB0,8),PKW(pB0,10),PKW(pB0,12),PKW(pB0,14)};pw2=(u32x4){PKW(pB1,0),PKW(pB1,2),PKW(pB1,4),PKW(pB1,6)};pw3=(u32x4){PKW(pB1,8),PKW(pB1,10),PKW(pB1,12),PKW(pB1,14)};
    SBAR(); pv(o,vb0+sl_cur,PAF(0),PAF(1),PAF(2),PAF(3)); }
  #undef PKW
  #undef PAF
  #undef VFR
  #undef PIN
  #undef MX3
  #undef GAPA
  #undef GAPB
  #undef EX
  #undef VRD
  #undef KRD
  #undef STEP
  #undef ENDW
  #undef MROT
  {auto rr=__builtin_amdgcn_permlane32_swap(__float_as_uint(l_reg),__float_as_uint(l_reg),false,false);l_reg=__uint_as_float(rr[0])+__uint_as_float(rr[1]);}
  if(hi==0)wsf[32+r32]=l_reg;asm volatile("s_waitcnt lgkmcnt(0)":::"memory");
  float rli[16];
  #pragma unroll
  for(int r=0;r<16;++r)rli[r]=__builtin_amdgcn_rcpf(wsf[32+crow(r,hi)]);
  bf16*Ow=O+(rowbase+q0+wid*QBLK)*OP;
  { bf16*stg=(bf16*)(shm+LDS_OST)+wid*2048;
    #pragma unroll
    for(int r=0;r<16;++r){const int orow=crow(r,hi);
      #pragma unroll
      for(int d0=0;d0<2;++d0)stg[orow*64+d0*32+r32]=__float2bfloat16(o[d0][r]*rli[r]);}
    asm volatile("s_waitcnt lgkmcnt(0)":::"memory");
    #pragma unroll
    for(int i=0;i<4;++i){const int row=i*8+(lane>>3),ch=lane&7; const u32x4 v=*(const u32x4*)(stg+row*64+ch*8); ATTN_STORE16(Ow+(long)row*OP+ch*8,v);} }
  asm volatile("s_waitcnt lgkmcnt(0)\n\ts_barrier":::"memory");
  #undef DMA_K
  #undef DMA_V
  #undef CMASK
  #undef START
  #undef RESC
  #undef ROT
}
constexpr int ATTN_LDS_BYTES=LDS_BYTES;
#undef SBAR
#undef WAIT_BAR
}
constexpr int IX_SLOT = 8288;
constexpr int IX_BINS = 384;
constexpr int IX_HC_OFF = 4 * IX_SLOT * 4;
constexpr int IX_HC_ROW = 2048, IX_CAP = 256;
constexpr int IX_MB_OFF = IX_HC_OFF + 8 * IX_HC_ROW;
constexpr int IX_CNT_OFF = IX_MB_OFF + 8 * 128 * 8;
constexpr int IX_MM_OFF = IX_CNT_OFF + 32;
constexpr int IX_LDS = IX_MM_OFF + 64;
DI int ix_bin(float x, float lo, float scale) { const int b = (int)((x - lo) * scale); return b > IX_BINS - 1 ? IX_BINS - 1 : b; }
DI float fkey_inv(unsigned k) { return __uint_as_float((k & 0x80000000u) ? (k & 0x7fffffffu) : ~k); }

DI void index_phase(unsigned char* ws, char* ldsc, int G, int bx, const int wid_s, const int sub) {
    const int lane = lane_id_asm(), wid = wid_s, r32 = lane & 31, hi = lane >> 5;
    float* sc = (float*)ldsc;
    char* hcA = ldsc + IX_HC_OFF;
    unsigned* mb32 = (unsigned*)(ldsc + IX_MB_OFF);
    unsigned* cntA = (unsigned*)(ldsc + IX_CNT_OFF);
    unsigned* mmA = (unsigned*)(ldsc + IX_MM_OFF);
    const bf16_t* QI = (const bf16_t*)(ws + WS_QI); const bf16_t* KI = (const bf16_t*)(ws + WS_KI); const float* WI = (const float*)(ws + WS_WI);
    u64* MASK = (u64*)(ws + WS_MASK);
    for (int i = lane; i < IX_BINS; i += 64) ((unsigned*)(hcA + wid * IX_HC_ROW))[i] = 0u;
    for (int i = lane; i < 256; i += 64) mb32[wid * 256 + i] = 0u;
    if (lane == 0) { cntA[wid] = 0u; mmA[2 * wid] = 0xFFFFFFFFu; mmA[2 * wid + 1] = 0u; }
    __syncthreads();
    for (int item = bx; item < 2048; item += G) {
        const int b = item >> 10, j = item & 1023, gA = 2047 - j, gB = j, rowbase = b * S;
        const int nA = 4 * gA + 4, nB = 4 * gB + 4, offB = (nA + 63) & ~63;
        {
            bf16x8 qa0, qa1, qb0, qb1; float wa[16], wb[16];
            { const int row = r32 & 3, head = r32 >> 2;
              const bf16_t* pa = QI + (size_t)(rowbase + 4 * gA + row) * 256 + head * 32 + 8 * hi; qa0 = *(const bf16x8*)pa; qa1 = *(const bf16x8*)(pa + 16);
              const bf16_t* pb = QI + (size_t)(rowbase + 4 * gB + row) * 256 + head * 32 + 8 * hi; qb0 = *(const bf16x8*)pb; qb1 = *(const bf16x8*)(pb + 16); }
#pragma unroll
            for (int jj = 0; jj < 4; ++jj)
#pragma unroll
                for (int row = 0; row < 4; ++row) {
                    wa[4 * jj + row] = WI[(size_t)(rowbase + 4 * gA + row) * 8 + 2 * jj + hi];
                    wb[4 * jj + row] = WI[(size_t)(rowbase + 4 * gB + row) * 8 + 2 * jj + hi];
                }
            const int ntAr = (nA + 31) >> 5, ntB = (nB + 31) >> 5;
            const f32x16 zero = {};
            float mnA0 = INFINITY, mnA1 = INFINITY, mxA0 = -INFINITY, mxA1 = -INFINITY, mnB0 = INFINITY, mnB1 = INFINITY, mxB0 = -INFINITY, mxB1 = -INFINITY;
            const bf16_t* kp = KI + (size_t)(rowbase + 32 * wid + r32) * 32 + 8 * hi;
            bf16x8 k0 = *(const bf16x8*)kp, k1 = *(const bf16x8*)(kp + 16);
            for (int k = wid; k < ntAr; k += 8) {
                const bf16x8 c0 = k0, c1 = k1;
                kp += 8 * 32 * 32;
                if (k + 8 < ntAr) { k0 = *(const bf16x8*)kp; k1 = *(const bf16x8*)(kp + 16); }
                const int key = 32 * k + r32;
                {
                    f32x16 acc = MFMA32(qa0, c0, zero); acc = MFMA32(qa1, c1, acc);
                    attn_body::f32x2_t t01 = {0.f, 0.f}, t23 = {0.f, 0.f};
#pragma unroll
                    for (int jj = 0; jj < 4; ++jj) {
                        const attn_body::f32x2_t r01 = {fmaxf(acc[4 * jj], 0.f), fmaxf(acc[4 * jj + 1], 0.f)}, r23 = {fmaxf(acc[4 * jj + 2], 0.f), fmaxf(acc[4 * jj + 3], 0.f)};
                        t01 = __builtin_elementwise_fma((attn_body::f32x2_t){wa[4 * jj], wa[4 * jj + 1]}, r01, t01); t23 = __builtin_elementwise_fma((attn_body::f32x2_t){wa[4 * jj + 2], wa[4 * jj + 3]}, r23, t23);
                    }
                    float s[4]; const float tt[4] = {t01.x, t01.y, t23.x, t23.y};
#pragma unroll
                    for (int row = 0; row < 4; ++row) {
                        const auto rr = __builtin_amdgcn_permlane32_swap(__float_as_uint(tt[row]), __float_as_uint(tt[row]), false, false);
                        s[row] = __uint_as_float(rr[0]) + __uint_as_float(rr[1]);
                    }
                    const float v0 = hi ? s[2] : s[0], v1 = hi ? s[3] : s[1];
                    sc[(2 * hi) * IX_SLOT + key] = v0; sc[(2 * hi + 1) * IX_SLOT + key] = v1;
                    mnA0 = fminf(mnA0, v0); mxA0 = fmaxf(mxA0, v0); mnA1 = fminf(mnA1, v1); mxA1 = fmaxf(mxA1, v1);
                }
                if (k < ntB) {
                    f32x16 acc = MFMA32(qb0, c0, zero); acc = MFMA32(qb1, c1, acc);
                    attn_body::f32x2_t t01 = {0.f, 0.f}, t23 = {0.f, 0.f};
#pragma unroll
                    for (int jj = 0; jj < 4; ++jj) {
                        const attn_body::f32x2_t r01 = {fmaxf(acc[4 * jj], 0.f), fmaxf(acc[4 * jj + 1], 0.f)}, r23 = {fmaxf(acc[4 * jj + 2], 0.f), fmaxf(acc[4 * jj + 3], 0.f)};
                        t01 = __builtin_elementwise_fma((attn_body::f32x2_t){wb[4 * jj], wb[4 * jj + 1]}, r01, t01); t23 = __builtin_elementwise_fma((attn_body::f32x2_t){wb[4 * jj + 2], wb[4 * jj + 3]}, r23, t23);
                    }
                    float s[4]; const float tt[4] = {t01.x, t01.y, t23.x, t23.y};
#pragma unroll
                    for (int row = 0; row < 4; ++row) {
                        const auto rr = __builtin_amdgcn_permlane32_swap(__float_as_uint(tt[row]), __float_as_uint(tt[row]), false, false);
                        s[row] = __uint_as_float(rr[0]) + __uint_as_float(rr[1]);
                    }
                    const float v0 = hi ? s[2] : s[0], v1 = hi ? s[3] : s[1];
                    sc[(2 * hi) * IX_SLOT + offB + key] = v0; sc[(2 * hi + 1) * IX_SLOT + offB + key] = v1;
                    mnB0 = fminf(mnB0, v0); mxB0 = fmaxf(mxB0, v0); mnB1 = fminf(mnB1, v1); mxB1 = fmaxf(mxB1, v1);
                }
            }
#pragma unroll
            for (int o = 1; o < 32; o <<= 1) {
                mnA0 = fminf(mnA0, __shfl_xor(mnA0, o)); mxA0 = fmaxf(mxA0, __shfl_xor(mxA0, o)); mnA1 = fminf(mnA1, __shfl_xor(mnA1, o)); mxA1 = fmaxf(mxA1, __shfl_xor(mxA1, o));
                mnB0 = fminf(mnB0, __shfl_xor(mnB0, o)); mxB0 = fmaxf(mxB0, __shfl_xor(mxB0, o)); mnB1 = fminf(mnB1, __shfl_xor(mnB1, o)); mxB1 = fmaxf(mxB1, __shfl_xor(mxB1, o));
            }
            if (r32 == 0) {
                atomicMin(&mmA[2 * (2 * hi)], fkey(mnA0)); atomicMax(&mmA[2 * (2 * hi) + 1], fkey(mxA0)); atomicMin(&mmA[2 * (2 * hi + 1)], fkey(mnA1)); atomicMax(&mmA[2 * (2 * hi + 1) + 1], fkey(mxA1));
                atomicMin(&mmA[2 * (4 + 2 * hi)], fkey(mnB0)); atomicMax(&mmA[2 * (4 + 2 * hi) + 1], fkey(mxB0)); atomicMin(&mmA[2 * (5 + 2 * hi)], fkey(mnB1)); atomicMax(&mmA[2 * (5 + 2 * hi) + 1], fkey(mxB1));
            }
        }
        __syncthreads();
        if (!(sub & 4)) {
            const int p = wid & 3, h = wid >> 2;
            int bst[2] = {0, 0};
#pragma unroll
            for (int ab = 0; ab < 2 && !(sub & 8); ++ab) {
                const int row = 4 * ab + p, n = 4 * (ab ? gB : gA) + p + 1;
                if (n > 256) {
                    const float* base = sc + p * IX_SLOT + (ab ? offB : 0);
                    const float lo = fkey_inv(mmA[2 * row]), hv = fkey_inv(mmA[2 * row + 1]);
                    const float scale = (hv > lo) ? (float)IX_BINS / (hv - lo) : 0.f;
                    unsigned* hist = (unsigned*)(hcA + row * IX_HC_ROW);
#pragma unroll 2
                    for (int i = 256 * h + lane * 4; i < n; i += 512) {
                        const f32x4 v = *(const f32x4*)(base + i);
#pragma unroll
                        for (int e = 0; e < 4; ++e) if (i + e < n) __hip_atomic_fetch_add(&hist[ix_bin(v[e], lo, scale)], 1u, __ATOMIC_RELAXED, __HIP_MEMORY_SCOPE_WORKGROUP);
                    }
                }
            }
            __syncthreads();
#pragma unroll
            for (int ab = 0; ab < 2 && !(sub & 16); ++ab) {
                const int row = 4 * ab + p, n = 4 * (ab ? gB : gA) + p + 1;
                if (n > 256) {
                    const unsigned* hist = (const unsigned*)(hcA + row * IX_HC_ROW);
                    unsigned hc[6];
#pragma unroll
                    for (int e = 0; e < 6; ++e) hc[e] = hist[6 * lane + e];
                    unsigned Ssum = (hc[0] + hc[1]) + (hc[2] + hc[3]) + (hc[4] + hc[5]);
#pragma unroll
                    for (int o = 1; o < 64; o <<= 1) { const unsigned v = __shfl_down(Ssum, o); if (lane + o < 64) Ssum += v; }
                    const u64 balS = __ballot(Ssum >= 256u);
                    const int Ls = 63 - __clzll((long long)balS);
                    const unsigned Snext = __shfl_down(Ssum, 1);
                    unsigned cum = (lane < 63) ? Snext : 0u; int bsel = 0; bool found = false;
#pragma unroll
                    for (int e = 5; e >= 0; --e) { if (!found) { if (cum + hc[e] >= 256u) { bsel = 6 * lane + e; found = true; } else cum += hc[e]; } }
                    bst[ab] = __shfl(bsel, Ls);
                }
            }
            __syncthreads();
#pragma unroll
            for (int ab = 0; ab < 2 && !(sub & 16); ++ab) {
                const int row = 4 * ab + p, n = 4 * (ab ? gB : gA) + p + 1;
                const float* base = sc + p * IX_SLOT + (ab ? offB : 0);
                u64* mb = (u64*)(mb32 + row * 256);
                if (n > 256) {
                    const float lo = fkey_inv(mmA[2 * row]), hv = fkey_inv(mmA[2 * row + 1]);
                    const float scale = (hv > lo) ? (float)IX_BINS / (hv - lo) : 0.f;
                    const int bstar = bst[ab];
                    uint2* clist = (uint2*)(hcA + row * IX_HC_ROW);
                    for (int c0 = 256 * h; c0 < n; c0 += 512) {
                        float xv[4];
#pragma unroll
                        for (int u = 0; u < 4; ++u) { const int i = c0 + 64 * u + lane; xv[u] = (i < n) ? base[i] : 0.f; }
#pragma unroll
                        for (int u = 0; u < 4; ++u) {
                            const int i = c0 + 64 * u + lane;
                            if (c0 + 64 * u < n) {
                                const int bn = (i < n) ? ix_bin(xv[u], lo, scale) : -1;
                                const u64 bsel64 = __ballot(bn > bstar), bcand = __ballot(bn == bstar);
                                if (lane == 0) mb[(c0 >> 6) + u] = bsel64;
                                if (bcand) {
                                    unsigned pos0 = 0u; if (lane == 0) pos0 = atomicAdd(&cntA[row], (unsigned)__popcll(bcand));
                                    pos0 = __shfl(pos0, 0);
                                    if (bn == bstar) { const unsigned pos = pos0 + (unsigned)__popcll(bcand & ((1ull << lane) - 1ull)); if (pos < (unsigned)IX_CAP) clist[pos] = make_uint2(fkey(xv[u]), (unsigned)i); }
                                }
                            }
                        }
                    }
                } else if (h == 0) {
                    if (lane < 4) { const int lo64 = 64 * lane; mb[lane] = (n - lo64 >= 64) ? ~0ull : (n > lo64 ? ((1ull << (n - lo64)) - 1ull) : 0ull); }
                }
            }
            __syncthreads();
            if (!(sub & 32)) {
                const int row = wid, slot = wid & 3, isB = wid >> 2, t = 4 * (isB ? gB : gA) + slot, n = t + 1;
                const float* base = sc + slot * IX_SLOT + (isB ? offB : 0);
                const size_t R = (size_t)rowbase + t;
                const int nw_all = 4 * (t >> 8) + 4;
                unsigned* mbr = mb32 + row * 256; u64* mb = (u64*)mbr;
                if (n > 256) {
                    const int m = (int)cntA[row];
                    unsigned above = 0u;
                    { const u64 w0 = mb[lane], w1 = mb[64 + lane]; above = (unsigned)(__popcll(w0) + __popcll(w1)); above = wave_sum_u(above); }
                    const int need = 256 - (int)above;
                    uint2* clist = (uint2*)(hcA + row * IX_HC_ROW);
                    if (m <= IX_CAP) {
                        unsigned mu[4], mk[4]; int rank[4];
#pragma unroll
                        for (int q = 0; q < 4; ++q) { mu[q] = 0u; mk[q] = 0u; rank[q] = 0; if (lane + 64 * q < m) { const uint2 e = clist[lane + 64 * q]; mu[q] = e.x; mk[q] = e.y; } }
                        for (int jx = 0; jx < m; ++jx) {
                            const uint2 e = clist[jx];
#pragma unroll
                            for (int q = 0; q < 4; ++q) rank[q] += ((e.x > mu[q]) || (e.x == mu[q] && e.y < mk[q])) ? 1 : 0;
                        }
#pragma unroll
                        for (int q = 0; q < 4; ++q) if (lane + 64 * q < m && rank[q] < need) atomicOr(&mbr[mk[q] >> 5], 1u << (mk[q] & 31u));
                    } else if (!(sub & 64)) {
                        const int bstar = isB ? bst[1] : bst[0];
                        const float lo = fkey_inv(mmA[2 * row]), hv = fkey_inv(mmA[2 * row + 1]);
                        const float scale = (hv > lo) ? (float)IX_BINS / (hv - lo) : 0.f;
                        unsigned* hist = (unsigned*)(hcA + row * IX_HC_ROW); uint2* clist2 = (uint2*)(hcA + row * IX_HC_ROW + IX_BINS * 4);
                        for (int i = lane; i < IX_BINS; i += 64) hist[i] = 0u;
                        __builtin_amdgcn_fence(__ATOMIC_ACQ_REL, "workgroup");
#pragma unroll 2
                        for (int i = lane * 4; i < n; i += 256) {
                            const f32x4 v = *(const f32x4*)(base + i);
#pragma unroll
                            for (int e = 0; e < 4; ++e) if (i + e < n) {
                                const float tt = (v[e] - lo) * scale; const int bn = (int)tt > IX_BINS - 1 ? IX_BINS - 1 : (int)tt;
                                if (bn == bstar) { const int sb = (int)((tt - (float)bstar) * (float)IX_BINS); __hip_atomic_fetch_add(&hist[sb > IX_BINS - 1 ? IX_BINS - 1 : sb], 1u, __ATOMIC_RELAXED, __HIP_MEMORY_SCOPE_WORKGROUP); }
                            }
                        }
                        __builtin_amdgcn_fence(__ATOMIC_ACQ_REL, "workgroup");
                        unsigned hc[6];
#pragma unroll
                        for (int e = 0; e < 6; ++e) hc[e] = hist[6 * lane + e];
                        unsigned Ssum = (hc[0] + hc[1]) + (hc[2] + hc[3]) + (hc[4] + hc[5]);
#pragma unroll
                        for (int o = 1; o < 64; o <<= 1) { const unsigned v = __shfl_down(Ssum, o); if (lane + o < 64) Ssum += v; }
                        const u64 balS = __ballot(Ssum >= (unsigned)need);
                        const int Ls = 63 - __clzll((long long)balS);
                        const unsigned Snext = __shfl_down(Ssum, 1);
                        unsigned cum = (lane < 63) ? Snext : 0u; int bsel = 0; unsigned abv = 0u; bool found = false;
#pragma unroll
                        for (int e = 5; e >= 0; --e) { if (!found) { if (cum + hc[e] >= (unsigned)need) { bsel = 6 * lane + e; abv = cum; found = true; } else cum += hc[e]; } }
                        const int b2 = __shfl(bsel, Ls); const int need2 = need - (int)__shfl(abv, Ls);
                        int m2 = 0;
                        for (int c0 = 0; c0 < n; c0 += 64) {
                            const int i = c0 + lane; const float xx = (i < n) ? base[i] : 0.f;
                            const float tt = (xx - lo) * scale; const int bn = (int)tt > IX_BINS - 1 ? IX_BINS - 1 : (int)tt;
                            int sb = (int)((tt - (float)bstar) * (float)IX_BINS); sb = sb > IX_BINS - 1 ? IX_BINS - 1 : sb;
                            const bool inb = (i < n) && bn == bstar;
                            const u64 bup = __ballot(inb && sb > b2), bcd = __ballot(inb && sb == b2);
                            if (lane == 0 && bup) mb[c0 >> 6] |= bup;
                            if (inb && sb == b2) { const int pos = m2 + __popcll(bcd & ((1ull << lane) - 1ull)); if (pos < 64) clist2[pos] = make_uint2(fkey(xx), (unsigned)i); }
                            m2 += __popcll(bcd);
                        }
                        __builtin_amdgcn_fence(__ATOMIC_ACQ_REL, "workgroup");
                        if (m2 <= 64) {
                            unsigned mu = 0u, mk = 0u; if (lane < m2) { const uint2 e = clist2[lane]; mu = e.x; mk = e.y; }
                            int rank = 0;
                            for (int jx = 0; jx < m2; ++jx) { const unsigned uj = __shfl(mu, jx), kj = __shfl(mk, jx); rank += ((uj > mu) || (uj == mu && kj < mk)) ? 1 : 0; }
                            if (lane < m2 && rank < need2) atomicOr(&mbr[mk >> 5], 1u << (mk & 31u));
                        } else {
                            unsigned Tb = 0u;
                            for (int bit = 31; bit >= 0; --bit) {
                                const unsigned cd = Tb | (1u << bit); unsigned c = 0u;
                                for (int i = lane; i < n; i += 64) c += (fkey(base[i]) >= cd) ? 1u : 0u;
                                if (wave_sum_u(c) >= 256u) Tb = cd;
                            }
                            unsigned cg = 0u; for (int i = lane; i < n; i += 64) cg += (fkey(base[i]) > Tb) ? 1u : 0u;
                            const unsigned nd = 256u - wave_sum_u(cg);
                            int lk = 0, hk = n - 1;
                            while (lk < hk) { const int mid = (lk + hk) >> 1; unsigned c = 0u; for (int i = lane; i <= mid; i += 64) c += (fkey(base[i]) == Tb) ? 1u : 0u; if (wave_sum_u(c) >= nd) hk = mid; else lk = mid + 1; }
                            for (int c = 0; 64 * c < n; ++c) {
                                const int i = 64 * c + lane; const unsigned uk = (i < n) ? fkey(base[i]) : 0u;
                                const u64 bal = __ballot((i < n) && (uk > Tb || (uk == Tb && i <= lk)));
                                if (lane == 0) mb[c] = bal;
                            }
                        }
                    }
                }
                __builtin_amdgcn_fence(__ATOMIC_ACQ_REL, "workgroup");
                { const u64 w0 = mb[lane], w1 = mb[64 + lane];
                  if (lane < nw_all) MASK[R * 128 + lane] = w0;
                  if (64 + lane < nw_all) MASK[R * 128 + 64 + lane] = w1; }
                for (int i = lane; i < IX_BINS; i += 64) ((unsigned*)(hcA + row * IX_HC_ROW))[i] = 0u;
                for (int i = lane; i < 256; i += 64) mbr[i] = 0u;
                if (lane == 0) { cntA[row] = 0u; mmA[2 * row] = 0xFFFFFFFFu; mmA[2 * row + 1] = 0u; }
            }
        }
        __syncthreads();
    }
}
#define XB_TMO      128
#define XB_XCNT(j)  (256  + 64 * (j))
#define XB_XSUB(j)  (1280 + 64 * (j))
#define XB_XGEN(j)  (2304 + 64 * (j))
#define XB_TOP      3328
#define XB_TOPGEN   3392
#define XCD_BAR_WORDS 3456
#define XB_SPIN_CAP (1u << 18)
#define LAS __attribute__((address_space(3)))

__device__ __forceinline__ unsigned xb_ld(unsigned* p)              { return __hip_atomic_load(p, __ATOMIC_RELAXED, __HIP_MEMORY_SCOPE_AGENT); }
__device__ __forceinline__ unsigned xb_add(unsigned* p, unsigned v) { return __hip_atomic_fetch_add(p, v, __ATOMIC_RELAXED, __HIP_MEMORY_SCOPE_AGENT); }
__device__ __forceinline__ unsigned xb_xcc_id() { return (unsigned)__builtin_amdgcn_s_getreg((3 << 11) | 20) & 0xFu; }
#define XB_SPIN(cond, bar) do { unsigned _sp = 0; while (cond) { __builtin_amdgcn_s_sleep(1); \
    if ((++_sp & 255u) == 0u) { if (xb_ld(&(bar)[XB_TMO])) break; if (_sp > XB_SPIN_CAP) { atomicAdd(&(bar)[XB_TMO], 1u); break; } } } } while (0)

struct XcdBarrier {
    unsigned* bar; unsigned x;
    volatile LAS unsigned* st;
};

__device__ __forceinline__ XcdBarrier xcd_barrier_post(unsigned* bar, volatile LAS unsigned* st, bool leader) {
    XcdBarrier b; b.bar = bar; b.x = xb_xcc_id(); b.st = st;
    if (leader) (void)xb_add(&bar[XB_XCNT(b.x)], 1u);
    return b;
}
__device__ __forceinline__ void xcd_barrier_complete(unsigned* bar, unsigned x, unsigned& nloc, unsigned& nx) {
    const unsigned G = gridDim.x * gridDim.y * gridDim.z;
    unsigned sum, cnt, mine, sp = 0u;
    for (;;) {
        sum = 0u; cnt = 0u; mine = 0u;
#pragma unroll
        for (unsigned j = 0; j < 16; ++j) { const unsigned c = xb_ld(&bar[XB_XCNT(j)]); sum += c; cnt += (c > 0u) ? 1u : 0u; mine = (j == x) ? c : mine; }
        if (sum == G) break;
        __builtin_amdgcn_s_sleep(1);
        if ((++sp & 255u) == 0u) { if (xb_ld(&bar[XB_TMO])) break; if (sp > XB_SPIN_CAP) { atomicAdd(&bar[XB_TMO], 1u); break; } }
    }
    nloc = mine > 0u ? mine : 1u; nx = cnt > 0u ? cnt : 1u;
}

__device__ __forceinline__ void xcd_barrier(const XcdBarrier& b, bool leader) {
    asm volatile("s_waitcnt vmcnt(0)" ::: "memory");
    __syncthreads();
    if (leader) {
        unsigned* bar = b.bar;
        __builtin_amdgcn_s_waitcnt(0);
        unsigned nloc = b.st[0], nx = b.st[1];
        if (nloc == 0u) { xcd_barrier_complete(bar, b.x, nloc, nx); b.st[0] = nloc; b.st[1] = nx; }
        const unsigned old = xb_add(&bar[XB_XSUB(b.x)], 1u);
        const unsigned gen = old / nloc;
        if (old + 1u == (gen + 1u) * nloc) {
            __builtin_amdgcn_fence(__ATOMIC_RELEASE, "agent");
            asm volatile("s_waitcnt vmcnt(0)" ::: "memory");
            const unsigned og = xb_add(&bar[XB_TOP], 1u);
            const unsigned tg = og / nx;
            if (og + 1u == (tg + 1u) * nx) xb_add(&bar[XB_TOPGEN], 1u);
            else XB_SPIN(xb_ld(&bar[XB_TOPGEN]) == tg, bar);
            __builtin_amdgcn_fence(__ATOMIC_ACQUIRE, "agent");
            xb_add(&bar[XB_XGEN(b.x)], 1u);
            asm volatile("s_waitcnt vmcnt(0)" ::: "memory");
        } else {
            XB_SPIN(xb_ld(&bar[XB_XGEN(b.x)]) == gen, bar);
            __builtin_amdgcn_fence(__ATOMIC_ACQUIRE, "agent");
            asm volatile("s_waitcnt vmcnt(0)" ::: "memory");
        }
    }
    __syncthreads();
}

using pg8::Unit;
typedef float f32x2_t __attribute__((ext_vector_type(2))); typedef __bf16 bf16x2_t __attribute__((ext_vector_type(2)));
DI unsigned cvtpk(float lo, float hi) { f32x2_t v = {lo, hi}; bf16x2_t b = __builtin_convertvector(v, bf16x2_t); return __builtin_bit_cast(unsigned, b); }
DI u32x4 pack8(const f32x4& a, const f32x4& b) { u32x4 w; w.x = cvtpk(a[0], a[1]); w.y = cvtpk(a[2], a[3]); w.z = cvtpk(b[0], b[1]); w.w = cvtpk(b[2], b[3]); return w; }
DI void unpack8(const u32x4& w, f32x4& a, f32x4& b) {
    a[0] = __uint_as_float(w.x << 16); a[1] = __uint_as_float(w.x & 0xffff0000u); a[2] = __uint_as_float(w.y << 16); a[3] = __uint_as_float(w.y & 0xffff0000u);
    b[0] = __uint_as_float(w.z << 16); b[1] = __uint_as_float(w.z & 0xffff0000u); b[2] = __uint_as_float(w.w << 16); b[3] = __uint_as_float(w.w & 0xffff0000u);
}
DI float sigmoidf_(float v) { return __builtin_amdgcn_rcpf(1.0f + __expf(-v)); }

struct EpiIn {
    static constexpr bool PERM = true, AFTER_DRAIN = false;
    unsigned char* ws; const float* ki_g; const float* ki_b; const float* gate_b;
    DI void operator()(const f32x4 (&acc)[2][2][4][2], const Unit& u, int wr, int wc, int fr, int fq) const {
        const int pn = u.pn, row0 = u.pm * 256 + wr * 64 + fr, cl0 = wc * 32 + 8 * fq;
        if (pn < 12) {
            const int seg = pn >> 1, kind = seg % 3;
            bf16_t* O = (bf16_t*)(ws + WS_QA + (size_t)seg * 16 * MiB) + (pn & 1) * 256 + cl0;
            const bool ropew = (kind != 2) && ((wc & 1) == 0);
            const float sc = (kind == 0) ? C2 : 1.0f, sg = (fq == 0) ? -1.0f : 1.0f;
            const float2* RH = (const float2*)(ws + WS_ROPE_H);
#pragma unroll
            for (int ai = 0; ai < 2; ++ai)
#pragma unroll
                for (int m = 0; m < 4; ++m) {
                    const int row = row0 + ai * 128 + m * 16;
                    f32x4 cs4[4];
                    if (ropew) { const f32x4* p = (const f32x4*)(RH + (size_t)row * 8); cs4[0] = p[0]; cs4[1] = p[1]; cs4[2] = p[2]; cs4[3] = p[3]; }
#pragma unroll
                    for (int bj = 0; bj < 2; ++bj) {
                        f32x4 v0 = acc[ai][bj][m][0], v1 = acc[ai][bj][m][1];
                        if (ropew) {
                            f32x4 p0, p1;
#pragma unroll
                            for (int i = 0; i < 4; ++i) { p0[i] = __shfl_xor(v0[i], 16); p1[i] = __shfl_xor(v1[i], 16); }
                            if (fq < 2) {
#pragma unroll
                                for (int i = 0; i < 4; ++i) {
                                    v0[i] = v0[i] * cs4[i >> 1][(i & 1) * 2] + sg * p0[i] * cs4[i >> 1][(i & 1) * 2 + 1];
                                    v1[i] = v1[i] * cs4[2 + (i >> 1)][(i & 1) * 2] + sg * p1[i] * cs4[2 + (i >> 1)][(i & 1) * 2 + 1];
                                }
                            }
                        }
                        v0 = v0 * sc; v1 = v1 * sc;
                        *(u32x4*)(O + (size_t)row * 512 + 128 * bj) = pack8(v0, v1);
                    }
                }
        } else if (pn == 12) {
            bf16_t* O = (bf16_t*)(ws + WS_QI) + cl0; const float2* RI = (const float2*)(ws + WS_ROPE_I);
#pragma unroll
            for (int ai = 0; ai < 2; ++ai)
#pragma unroll
                for (int m = 0; m < 4; ++m) {
                    const int row = row0 + ai * 128 + m * 16;
                    f32x4 ci[2];
                    if (fq == 0) { const f32x4* p = (const f32x4*)(RI + (size_t)row * 4); ci[0] = p[0]; ci[1] = p[1]; }
#pragma unroll
                    for (int bj = 0; bj < 2; ++bj) {
                        f32x4 v0 = acc[ai][bj][m][0], v1 = acc[ai][bj][m][1];
                        if (fq == 0) {
#pragma unroll
                            for (int i = 0; i < 4; ++i) { const float c = ci[i >> 1][(i & 1) * 2], s = ci[i >> 1][(i & 1) * 2 + 1], a = v0[i], b = v1[i]; v0[i] = a * c - b * s; v1[i] = b * c + a * s; }
                        }
                        *(u32x4*)(O + (size_t)row * 256 + 128 * bj) = pack8(v0, v1);
                    }
                }
        } else if (pn == 13) {
            if (wc == 0) {
                bf16_t* KI = (bf16_t*)(ws + WS_KI) + 8 * fq; const float2* RI = (const float2*)(ws + WS_ROPE_I);
                const f32x4 g0 = *(const f32x4*)(ki_g + 8 * fq), g1 = *(const f32x4*)(ki_g + 8 * fq + 4), b0 = *(const f32x4*)(ki_b + 8 * fq), b1 = *(const f32x4*)(ki_b + 8 * fq + 4);
#pragma unroll
                for (int ai = 0; ai < 2; ++ai)
#pragma unroll
                    for (int m = 0; m < 4; ++m) {
                        const int row = row0 + ai * 128 + m * 16;
                        f32x4 v0 = acc[ai][0][m][0], v1 = acc[ai][0][m][1];
                        float s = (v0[0] + v0[1]) + (v0[2] + v0[3]) + (v1[0] + v1[1]) + (v1[2] + v1[3]);
                        s += __shfl_xor(s, 16); s += __shfl_xor(s, 32);
                        const float mu = s * (1.0f / 32.0f);
                        v0 = v0 - mu; v1 = v1 - mu;
                        float q = (v0[0] * v0[0] + v0[1] * v0[1]) + (v0[2] * v0[2] + v0[3] * v0[3]) + (v1[0] * v1[0] + v1[1] * v1[1]) + (v1[2] * v1[2] + v1[3] * v1[3]);
                        q += __shfl_xor(q, 16); q += __shfl_xor(q, 32);
                        const float rs = 1.0f / sqrtf(q * (1.0f / 32.0f) + 1e-6f);
                        v0 = v0 * rs * g0 + b0; v1 = v1 * rs * g1 + b1;
                        if (fq == 0) {
                            const f32x4* p = (const f32x4*)(RI + (size_t)row * 4); const f32x4 c0 = p[0], c1 = p[1];
#pragma unroll
                            for (int i = 0; i < 4; ++i) { const float c = (i < 2 ? c0 : c1)[(i & 1) * 2], sn = (i < 2 ? c0 : c1)[(i & 1) * 2 + 1], a = v0[i], b = v1[i]; v0[i] = a * c - b * sn; v1[i] = b * c + a * sn; }
                        }
                        *(u32x4*)(KI + (size_t)row * 32) = pack8(v0, v1);
                    }
            } else if (wc == 1) {
                float* WI = (float*)(ws + WS_WI);
                if (fq == 0) {
#pragma unroll
                    for (int ai = 0; ai < 2; ++ai)
#pragma unroll
                        for (int m = 0; m < 4; ++m) {
                            const int row = row0 + ai * 128 + m * 16;
                            *(f32x4*)(WI + (size_t)row * 8) = acc[ai][0][m][0] * (1.0f / 16.0f); *(f32x4*)(WI + (size_t)row * 8 + 4) = acc[ai][0][m][1] * (1.0f / 16.0f);
                        }
                }
            }
        } else {
            const int cg0 = 256 * (pn - 14) + cl0; bf16_t* G = (bf16_t*)(ws + WS_G) + cg0;
#pragma unroll
            for (int bj = 0; bj < 2; ++bj) {
                const f32x4 gb0 = *(const f32x4*)(gate_b + cg0 + 128 * bj), gb1 = *(const f32x4*)(gate_b + cg0 + 128 * bj + 4);
#pragma unroll
                for (int ai = 0; ai < 2; ++ai)
#pragma unroll
                    for (int m = 0; m < 4; ++m) {
                        const int row = row0 + ai * 128 + m * 16;
                        f32x4 v0 = acc[ai][bj][m][0] + gb0, v1 = acc[ai][bj][m][1] + gb1;
#pragma unroll
                        for (int i = 0; i < 4; ++i) { v0[i] = sigmoidf_(v0[i]); v1[i] = sigmoidf_(v1[i]); }
                        *(u32x4*)(G + (size_t)row * 2048 + 128 * bj) = pack8(v0, v1);
                    }
            }
        }
    }
};
template <int PASS> struct EpiBranch {
    static constexpr bool PERM = true, AFTER_DRAIN = false;
    unsigned char* ws;
    DI void operator()(const f32x4 (&acc)[2][2][4][2], const Unit& u, int wr, int wc, int fr, int fq) const {
        const int row0 = u.pm * 256 + wr * 64 + fr, col0 = u.pn * 256 + wc * 32 + 8 * fq;
        const bf16_t* G = (const bf16_t*)(ws + WS_G) + (PASS - 1) * 1024 + col0; bf16_t* T = (bf16_t*)(ws + WS_T) + col0; bf16_t* MG = (bf16_t*)(ws + WS_MERGED) + col0;
#pragma unroll
        for (int ai = 0; ai < 2; ++ai)
#pragma unroll
            for (int m = 0; m < 4; ++m) {
                const int row = row0 + ai * 128 + m * 16;
#pragma unroll
                for (int bj = 0; bj < 2; ++bj) {
                    f32x4 g0, g1; unpack8(*(const u32x4*)(G + (size_t)row * 2048 + 128 * bj), g0, g1);
                    f32x4 r0 = g0 * acc[ai][bj][m][0], r1 = g1 * acc[ai][bj][m][1];
                    if (PASS == 2) { f32x4 t0, t1; unpack8(*(const u32x4*)(T + (size_t)row * 1024 + 128 * bj), t0, t1); r0 = r0 + t0; r1 = r1 + t1; }
                    *(u32x4*)((PASS == 1 ? T : MG) + (size_t)row * 1024 + 128 * bj) = pack8(r0, r1);
                }
            }
    }
};
template <bool WITH_BF> struct EpiRes {
    static constexpr bool PERM = false, AFTER_DRAIN = false;
    const float* base; float* dst; bf16_t* xb; float* RS;
    DI void operator()(const f32x4 (&acc)[2][2][4][2], const Unit& u, int wr, int wc, int fr, int fq) const {
        const int row0 = u.pm * 256 + wr * 64 + fr, col0 = u.pn * 256 + wc * 32 + 4 * fq;
#pragma unroll
        for (int ai = 0; ai < 2; ++ai)
#pragma unroll
            for (int m = 0; m < 4; ++m) {
                const int row = row0 + ai * 128 + m * 16; const size_t off = (size_t)row * 1024 + col0; float ss = 0.f;
#pragma unroll
                for (int bj = 0; bj < 2; ++bj)
#pragma unroll
                    for (int n = 0; n < 2; ++n) {
                        const f32x4 v = *(const f32x4*)(base + off + bj * 128 + n * 16) + acc[ai][bj][m][n];
                        *(f32x4*)(dst + off + bj * 128 + n * 16) = v;
                        if (WITH_BF) { uint2 w; w.x = cvtpk(v[0], v[1]); w.y = cvtpk(v[2], v[3]); *(uint2*)(xb + off + bj * 128 + n * 16) = w; }
                        ss += (v[0] * v[0] + v[1] * v[1]) + (v[2] * v[2] + v[3] * v[3]);
                    }
                ss += __shfl_xor(ss, 16); ss += __shfl_xor(ss, 32);
                if (fq == 0) RS[(size_t)row * 16 + u.pn * 4 + wc] = ss;
            }
    }
};
struct EpiFF1 {
    static constexpr bool PERM = true, AFTER_DRAIN = false;
    unsigned char* ws;
    DI void operator()(const f32x4 (&acc)[2][2][4][2], const Unit& u, int wr, int wc, int fr, int fq) const {
        const int row0 = u.pm * 256 + wr * 64 + fr, hc0 = u.pn * 128 + wc * 32 + 8 * fq;
        bf16_t* HF = (bf16_t*)(ws + WS_HF) + hc0; const float* RS = (const float*)(ws + WS_ROWSS1);
#pragma unroll
        for (int ai = 0; ai < 2; ++ai)
#pragma unroll
            for (int m = 0; m < 4; ++m) {
                const int row = row0 + ai * 128 + m * 16;
                const f32x4* rp = (const f32x4*)(RS + (size_t)row * 16); const f32x4 s4 = (rp[0] + rp[1]) + (rp[2] + rp[3]);
                const float rs = 1.0f / sqrtf(((s4[0] + s4[1]) + (s4[2] + s4[3])) * (1.0f / 1024.0f) + 1e-6f);
                f32x4 h0, h1;
#pragma unroll
                for (int i = 0; i < 4; ++i) {
                    const float g0 = acc[ai][0][m][0][i] * rs, g1 = acc[ai][0][m][1][i] * rs;
                    h0[i] = g0 * sigmoidf_(g0) * (acc[ai][1][m][0][i] * rs); h1[i] = g1 * sigmoidf_(g1) * (acc[ai][1][m][1][i] * rs);
                }
                *(u32x4*)(HF + (size_t)row * DFF) = pack8(h0, h1);
            }
    }
};

namespace cg = cooperative_groups;
constexpr int MK_THREADS = 512, MK_LDS = 159744, MK_MISC_OFF = MK_LDS - 64;
static_assert(IX_LDS <= MK_MISC_OFF && XCD_BAR_WORDS * 4 <= 16384 && attn_body::ATTN_LDS_BYTES <= MK_LDS && pg8::STAGE_BYTES <= MK_LDS, "LDS map");
struct MArgs { const float* in[19]; float* out; unsigned char* ws; int ph_lo, ph_hi, sub, pad; };
enum { PH_PRO = 0, PH_INPROJ = 1, PH_IXDIFF = 2, PH_DSACMB = 3, PH_BRANCH = 4, PH_OUT = 5, PH_FF1 = 6, PH_FF2 = 7, PH_FINAL = 8, PH_END = 9 };

DI void prologue_phase(const MArgs& a, char* ldsc, int vcu, int G, const int wid_s) {
    const int lane = lane_id_asm(), wid = wid_s;
    float* scr = (float*)ldsc + wid * (64 * 33);
    const int gw = vcu * 8 + wid, NGW = G * 8;
    unsigned char* ws = a.ws;
    for (int it = gw; it < IT_ALL; it += NGW) {
        int r = it;
        if (r < IT_IN) { transpose_item<1>(a.in[3], 1024, 5416, a.in[2], (bf16_t*)(ws + WS_WT_IN), r, 176, scr, lane); continue; } r -= IT_IN;
        if (r < IT_FF1) { transpose_item<2>(a.in[16], 1024, 5632, a.in[15], (bf16_t*)(ws + WS_WT_FF1), r, 176, scr, lane); continue; } r -= IT_FF1;
        if (r < IT_FF2) { transpose_item<0>(a.in[17], 2816, 1024, nullptr, (bf16_t*)(ws + WS_WT_FF2), r, 32, scr, lane); continue; } r -= IT_FF2;
        if (r < IT_OUT) { transpose_item<0>(a.in[14], 1024, 1024, nullptr, (bf16_t*)(ws + WS_WT_OUT), r, 32, scr, lane); continue; } r -= IT_OUT;
        if (r < IT_DSA) { transpose_item<0>(a.in[12], 512, 1024, nullptr, (bf16_t*)(ws + WS_WT_DSA), r, 32, scr, lane); continue; } r -= IT_DSA;
        transpose_item<0>(a.in[13], 512, 1024, nullptr, (bf16_t*)(ws + WS_WT_DIFF), r, 32, scr, lane);
    }
    const float* x = a.in[0]; const int* pos = (const int*)a.in[1];
    bf16_t* XN = (bf16_t*)(ws + WS_XN); float2* RH = (float2*)(ws + WS_ROPE_H); float2* RI = (float2*)(ws + WS_ROPE_I);
    for (int m = gw; m < M; m += NGW) {
        const f32x4* xr = (const f32x4*)(x + (size_t)m * D) + lane;
        f32x4 v[4]; float s = 0.f;
#pragma unroll
        for (int j = 0; j < 4; ++j) { v[j] = xr[64 * j]; s += (v[j].x * v[j].x + v[j].y * v[j].y) + (v[j].z * v[j].z + v[j].w * v[j].w); }
        const float rstd = 1.0f / sqrtf(wave_sum(s) * (1.f / D) + 1e-6f);
        u64* o8 = (u64*)(XN + (size_t)m * D) + lane;
#pragma unroll
        for (int j = 0; j < 4; ++j) o8[64 * j] = (u64)cvtpk(v[j].x * rstd, v[j].y * rstd) | ((u64)cvtpk(v[j].z * rstd, v[j].w * rstd) << 32);
        if (lane < 12) {
            const float p = (float)pos[m];
            const bool hd = lane < 8; const int j = hd ? lane : lane - 8;
            const float ex = hd ? -(float)(2 * j) / 16.0f : -(float)(2 * j) / 8.0f;
            const float ang = p * powf(ROPE_THETA, ex);
            float2 cs; cs.x = cosf(ang); cs.y = sinf(ang);
            if (hd) RH[(size_t)m * 8 + j] = cs; else RI[(size_t)m * 4 + j] = cs;
        }
    }
}
DI void combine_phase(const MArgs& a, int vcu, int G, const int wid_s) {
    const int lane = lane_id_asm(), gw = vcu * 8 + wid_s, NGW = G * 8;
    const bf16_t* OB1 = (const bf16_t*)((unsigned char*)a.out + DO_OB1); bf16_t* OBN = (bf16_t*)((unsigned char*)a.out + DO_OBN);
    const float s1 = wave_sum(a.in[6][lane] * a.in[7][lane]), s2 = wave_sum(a.in[8][lane] * a.in[9][lane]);
    const float lam = expf(s1) - expf(s2) + 0.2f;
    const float g0 = a.in[10][2 * lane], g1 = a.in[10][2 * lane + 1];
    for (int m = gw; m < M; m += NGW) {
#pragma unroll
        for (int h = 0; h < 4; ++h) {
            const unsigned aw = *(const unsigned*)(OB1 + (size_t)m * 1024 + (2 * h) * 128 + 2 * lane);
            const unsigned cw = *(const unsigned*)(OB1 + (size_t)m * 1024 + (2 * h + 1) * 128 + 2 * lane);
            const float v0 = __uint_as_float(aw << 16) - lam * __uint_as_float(cw << 16), v1 = __uint_as_float(aw & 0xffff0000u) - lam * __uint_as_float(cw & 0xffff0000u);
            const float ss = wave_sum(v0 * v0 + v1 * v1);
            const float rs = 0.8f / sqrtf(ss * (1.f / 128.f) + 1e-5f);
            *(unsigned*)(OBN + (size_t)m * 512 + h * 128 + 2 * lane) = cvtpk(v0 * rs * g0, v1 * rs * g1);
        }
    }
}
DI void final_phase(const MArgs& a, int vcu, int G, const int wid_s) {
    const int lane = lane_id_asm(), gw = vcu * 8 + wid_s, NGW = G * 8;
    const float* RS = (const float*)(a.ws + WS_ROWSS2); const f32x4* gv = (const f32x4*)a.in[18] + lane;
    for (int m = gw; m < M; m += NGW) {
        const f32x4* rp = (const f32x4*)(RS + (size_t)m * 16); const f32x4 s4 = (rp[0] + rp[1]) + (rp[2] + rp[3]);
        const float rs = 1.0f / sqrtf(((s4[0] + s4[1]) + (s4[2] + s4[3])) * (1.0f / 1024.0f) + 1e-6f);
        const f32x4* xi = (const f32x4*)((const float*)(a.ws + WS_X2) + (size_t)m * D) + lane; f32x4* o = (f32x4*)(a.out + (size_t)m * D) + lane;
#pragma unroll
        for (int j = 0; j < 4; ++j) { f32x4 v = xi[64 * j]; v = v * rs * gv[64 * j]; o[64 * j] = v; }
    }
}

__global__ void __launch_bounds__(MK_THREADS, 2) mk_fwd(MArgs a) {
    extern __shared__ __attribute__((aligned(16))) unsigned char lds_raw[];
    PG8_LAS unsigned char* lds = (PG8_LAS unsigned char*)lds_raw;
    unsigned char* ws = a.ws; unsigned char* dob = (unsigned char*)a.out;
    const int G = gridDim.x, bx = blockIdx.x;
    const int wid_s = __builtin_amdgcn_readfirstlane(threadIdx.x >> 6);
    const int vcu = (G % 8 == 0) ? (bx % 8) * (G / 8) + bx / 8 : bx;
#define INR(k) (a.ph_lo <= (k) && (k) < a.ph_hi)
#define IN(k) (INR(k) && !(a.sub & 256))
#define SEAM(k) do { if (INR(k) && INR((k) + 1)) xcd_barrier(xbar, leader); } while (0)
    volatile LAS unsigned* misc = (volatile LAS unsigned*)(lds + MK_MISC_OFF);
    if (threadIdx.x < 2) misc[threadIdx.x] = 0u;
    for (int i = bx * MK_THREADS + (int)threadIdx.x; i < 4096; i += G * MK_THREADS) ((unsigned*)(ws + WS_CTL))[i] = 0u;
    cg::this_grid().sync();
    const bool leader = (wid_s == 0) && (lane_id_asm() == 0);
    const XcdBarrier xbar = xcd_barrier_post((unsigned*)(ws + WS_CTL), misc, leader);
    if (IN(PH_PRO)) prologue_phase(a, (char*)lds_raw, vcu, G, wid_s);
    SEAM(PH_PRO);
    if (IN(PH_INPROJ)) {
        pg8::Gemm g{(const bf16_t*)(ws + WS_XN), (const bf16_t*)(ws + WS_WT_IN), M, NPROJ, 1024}; pg8::StaticOrder So; So.init(M, NPROJ, G, bx);
        EpiIn E{ws, a.in[4], a.in[5], a.in[11]};
        pg8::gemm_phase<EpiIn, pg8::StaticOrder, true, true>(lds, g, So, E, wid_s);
    }
    SEAM(PH_INPROJ);
    if (IN(PH_IXDIFF)) {
        if (a.sub & 1) index_phase(ws, (char*)lds_raw, G, bx, wid_s, a.sub);
        typedef attn_body::bf16 abf;
        for (int L = vcu; L < 256 && (a.sub & 2); L += G) {
            for (int i = 0; i < 4; ++i) {
                int Lo = L; asm volatile("" : "+s"(Lo));
                const int bh = Lo >> 3, s = Lo & 7, b = bh >> 4, p = bh & 15, hm = p >> 1, vh = p & 1, h = hm >> 1;
                const int qb = (i == 0) ? s : (i == 1) ? 15 - s : (i == 2) ? 16 + s : 31 - s;
                attn_body::attn_unit<8, 512, 512, 512, 1024, false>(b, qb, (const abf*)(ws + WS_QB) + hm * 64, (const abf*)(ws + WS_KB) + hm * 64, (const abf*)(ws + WS_VB) + h * 128 + vh * 64,
                                                                (abf*)(dob + DO_OB1) + hm * 128 + vh * 64, nullptr, (char*)lds_raw, wid_s);
            }
        }
    }
    SEAM(PH_IXDIFF);
    if (IN(PH_DSACMB)) {
        typedef attn_body::bf16 abf;
        for (int L = vcu; L < 256; L += G) {
            for (int i = 0; i < 2; ++i) {
                int Lo = L; asm volatile("" : "+s"(Lo));
                const int bh = Lo >> 4, s = Lo & 15, b = bh >> 3, h = bh & 7;
                const int qb = (i == 0) ? s : 31 - s;
                attn_body::attn_unit<8, 512, 512, 512, 512, true>(b, qb, (const abf*)(ws + WS_QA) + h * 64, (const abf*)(ws + WS_KA) + h * 64, (const abf*)(ws + WS_VA) + h * 64,
                                                              (abf*)(dob + DO_OA) + h * 64, (const u64*)(ws + WS_MASK), (char*)lds_raw, wid_s);
            }
        }
        combine_phase(a, vcu, G, wid_s);
    }
    SEAM(PH_DSACMB);
    if (IN(PH_BRANCH)) {
        { pg8::Gemm g{(const bf16_t*)(dob + DO_OA), (const bf16_t*)(ws + WS_WT_DSA), M, 1024, 512}; pg8::StaticOrder So; So.init(M, 1024, G, bx);
          EpiBranch<1> E{ws}; pg8::gemm_phase<EpiBranch<1>, pg8::StaticOrder, true, true>(lds, g, So, E, wid_s); }
        { pg8::Gemm g{(const bf16_t*)(dob + DO_OBN), (const bf16_t*)(ws + WS_WT_DIFF), M, 1024, 512}; pg8::StaticOrder So; So.init(M, 1024, G, bx);
          EpiBranch<2> E{ws}; pg8::gemm_phase<EpiBranch<2>, pg8::StaticOrder, true, true>(lds, g, So, E, wid_s); }
    }
    SEAM(PH_BRANCH);
    if (IN(PH_OUT)) {
        pg8::Gemm g{(const bf16_t*)(ws + WS_MERGED), (const bf16_t*)(ws + WS_WT_OUT), M, 1024, 1024}; pg8::StaticOrder So; So.init(M, 1024, G, bx);
        EpiRes<true> E{a.in[0], a.out, (bf16_t*)(ws + WS_X1B), (float*)(ws + WS_ROWSS1)};
        pg8::gemm_phase<EpiRes<true>, pg8::StaticOrder, true, true>(lds, g, So, E, wid_s);
    }
    SEAM(PH_OUT);
    if (IN(PH_FF1)) {
        pg8::Gemm g{(const bf16_t*)(ws + WS_X1B), (const bf16_t*)(ws + WS_WT_FF1), M, NFF1, 1024}; pg8::StaticOrder So; So.init(M, NFF1, G, bx);
        EpiFF1 E{ws}; pg8::gemm_phase<EpiFF1, pg8::StaticOrder, true, true>(lds, g, So, E, wid_s);
    }
    SEAM(PH_FF1);
    if (IN(PH_FF2)) {
        pg8::Gemm g{(const bf16_t*)(ws + WS_HF), (const bf16_t*)(ws + WS_WT_FF2), M, 1024, DFF}; pg8::StaticOrder So; So.init(M, 1024, G, bx);
        EpiRes<false> E{a.out, (float*)(ws + WS_X2), nullptr, (float*)(ws + WS_ROWSS2)};
        pg8::gemm_phase<EpiRes<false>, pg8::StaticOrder, true, true>(lds, g, So, E, wid_s);
    }
    SEAM(PH_FF2);
    if (IN(PH_FINAL)) final_phase(a, vcu, G, wid_s);
#undef IN
#undef INR
#undef SEAM
}

extern "C" void kernel_launch(void* const* d_in, const int* in_sizes, int n_in, void* d_out, int out_size, void* d_ws, size_t ws_size, hipStream_t stream) {
    if (n_in != 19 || out_size != M * D || ws_size < WS_END) { fprintf(stderr, "kernel_launch: unexpected shapes (n_in %d out %d ws %zu)\n", n_in, out_size, ws_size); return; }
    static int grid = 0;
    if (!grid) {
        if (hipFuncSetAttribute((const void*)mk_fwd, hipFuncAttributeMaxDynamicSharedMemorySize, MK_LDS) != hipSuccess) fprintf(stderr, "kernel_launch: hipFuncSetAttribute failed\n");
        int dev = 0, cus = 0, per_cu = 0;
        hipGetDevice(&dev); hipDeviceGetAttribute(&cus, hipDeviceAttributeMultiprocessorCount, dev);
        if (hipOccupancyMaxActiveBlocksPerMultiprocessor(&per_cu, (const void*)mk_fwd, MK_THREADS, MK_LDS) != hipSuccess || per_cu < 1) { fprintf(stderr, "kernel_launch: occupancy query gave %d\n", per_cu); per_cu = 1; }
        grid = cus * per_cu;
        (void)hipGetLastError();
    }
    MArgs ma{};
    for (int i = 0; i < 19; ++i) ma.in[i] = (const float*)d_in[i];
    ma.out = (float*)d_out; ma.ws = (unsigned char*)d_ws; ma.ph_lo = 0; ma.ph_hi = PH_END; ma.sub = 3;
    void* args[] = {&ma};
    const hipError_t e = hipLaunchCooperativeKernel((const void*)mk_fwd, dim3(grid), dim3(MK_THREADS), args, MK_LDS, stream);
    if (e != hipSuccess) fprintf(stderr, "kernel_launch: cooperative launch failed: %s (grid %d)\n", hipGetErrorString(e), grid);
}
```
